# Optimizing an MI355X kernel written in HIP

```python
import jax, jax.numpy as jnp
from jax import lax
import numpy as np

D_MODEL = 1024
BATCH = 8
SEQ = 4096
DEPTH = 1

CONV_WIDTH_A = D_MODEL // 2
CONV_K = 3
N_HEADS = 8
HEAD_DIM = 64
N_KV_GROUPS = 2
HEADS_PER_GROUP = N_HEADS // N_KV_GROUPS
ATTN_WIDTH = N_HEADS * HEAD_DIM
KV_WIDTH = N_KV_GROUPS * HEAD_DIM
CMP_BLOCK = 32
CMP_STRIDE = 16
SEL_BLOCK = 64
N_SEL = 16
WINDOW = 512
Q_BLOCK = 128
N_NSA_BRANCH = 3
ROPE_THETA = 10000.0
D_FF = 2816
N_MERGE = 2
EPS = 1e-6
NEG = -1e30
FORCE = 1e9

SPLIT_SIZES = [CONV_WIDTH_A, CONV_WIDTH_A, CONV_WIDTH_A, ATTN_WIDTH] + [KV_WIDTH] * 6 + [N_NSA_BRANCH * N_HEADS, N_MERGE * D_MODEL]
IN_COLS = sum(SPLIT_SIZES)

kernel_name = "hybrid_shortconv_nsa_convffn_block"


def rmsnorm(x, g):
    x32 = x.astype(jnp.float32)
    y = x32 * lax.rsqrt(jnp.mean(x32 * x32, axis=-1, keepdims=True) + EPS)
    return (y * g.astype(jnp.float32)).astype(x.dtype)


def causal_dwconv(u, w):
    s = u.shape[1]
    up = jnp.pad(u, ((0, 0), (CONV_K - 1, 0), (0, 0)))
    y = w[0] * up[:, 0:s]
    for k in range(1, CONV_K):
        y = y + w[k] * up[:, k:k + s]
    return y


def rope(x, positions):
    half = HEAD_DIM // 2
    inv = ROPE_THETA ** (-jnp.arange(half, dtype=jnp.float32) / half)
    ang = positions.astype(jnp.float32)[..., None] * inv
    cos = jnp.cos(ang)[:, :, None, :]
    sin = jnp.sin(ang)[:, :, None, :]
    x32 = x.astype(jnp.float32)
    x1, x2 = x32[..., :half], x32[..., half:]
    out = jnp.concatenate([x1 * cos - x2 * sin, x2 * cos + x1 * sin], axis=-1)
    return out.astype(x.dtype)


def compress(kv, pe, w1, w2):
    b, s = kv.shape[0], kv.shape[1]
    n_cmp = (s - CMP_BLOCK) // CMP_STRIDE + 1
    idx = np.arange(n_cmp)[:, None] * CMP_STRIDE + np.arange(CMP_BLOCK)[None, :]
    blk = kv[:, idx] + pe[None, None, :, None, :]
    blk = blk.transpose(0, 1, 3, 2, 4).reshape(b, n_cmp, N_KV_GROUPS, CMP_BLOCK * HEAD_DIM)
    return jax.nn.silu(blk @ w1) @ w2


def masked_softmax(s, mask):
    p = jax.nn.softmax(jnp.where(mask, s, NEG), axis=-1)
    return jnp.where(mask, p, 0.0)


def nsa(q, k_cmp, v_cmp, k_sel, v_sel, k_win, v_win, gates):
    b, s = q.shape[0], q.shape[1]
    n_cmp = k_cmp.shape[1]
    n_blk = s // SEL_BLOCK
    n_sel = min(N_SEL, n_blk)
    n_qb = s // Q_BLOCK
    scale = HEAD_DIM ** -0.5
    cmp_end = jnp.arange(n_cmp) * CMP_STRIDE + CMP_BLOCK - 1
    ii = np.arange(n_cmp)[:, None] * CMP_STRIDE
    jj = np.arange(n_blk)[None, :] * SEL_BLOCK
    overlap = jnp.asarray(((ii < jj + SEL_BLOCK) & (ii + CMP_BLOCK > jj)).astype(np.float32))
    ksb = k_sel.reshape(b, n_blk, SEL_BLOCK, N_KV_GROUPS, HEAD_DIM).transpose(0, 3, 1, 2, 4)
    vsb = v_sel.reshape(b, n_blk, SEL_BLOCK, N_KV_GROUPS, HEAD_DIM).transpose(0, 3, 1, 2, 4)
    kwp = jnp.pad(k_win, ((0, 0), (WINDOW, 0), (0, 0), (0, 0)))
    vwp = jnp.pad(v_win, ((0, 0), (WINDOW, 0), (0, 0), (0, 0)))
    b_ix = jnp.arange(b)[:, None, None, None]
    g_ix = jnp.arange(N_KV_GROUPS)[None, :, None, None]
    blk_ids = jnp.arange(n_blk)

    def query_block(qb):
        t0 = qb * Q_BLOCK
        t = t0 + jnp.arange(Q_BLOCK)
        qc = lax.dynamic_slice_in_dim(q, t0, Q_BLOCK, axis=1).reshape(b, Q_BLOCK, N_KV_GROUPS, HEADS_PER_GROUP, HEAD_DIM)
        gc = lax.dynamic_slice_in_dim(gates, t0, Q_BLOCK, axis=1).reshape(b, Q_BLOCK, N_KV_GROUPS, HEADS_PER_GROUP, N_NSA_BRANCH)
        sc = jnp.einsum('bqghd,bkgd->bghqk', qc, k_cmp).astype(jnp.float32) * scale
        p_c = masked_softmax(sc, cmp_end[None, :] <= t[:, None])
        o_c = jnp.einsum('bghqk,bkgd->bqghd', p_c.astype(v_cmp.dtype), v_cmp)
        imp = jnp.einsum('bghqk,kj->bgqj', p_c, overlap)
        cur = t // SEL_BLOCK
        forced = (blk_ids[None, :] == 0) | (blk_ids[None, :] == cur[:, None]) | (blk_ids[None, :] == cur[:, None] - 1)
        valid = blk_ids[None, :] <= cur[:, None]
        imp = jnp.where(forced, FORCE, jnp.where(valid, imp, -FORCE))
        _, sel = lax.top_k(imp, n_sel)
        ks = ksb[b_ix, g_ix, sel].reshape(b, N_KV_GROUPS, Q_BLOCK, n_sel * SEL_BLOCK, HEAD_DIM)
        vs = vsb[b_ix, g_ix, sel].reshape(b, N_KV_GROUPS, Q_BLOCK, n_sel * SEL_BLOCK, HEAD_DIM)
        kpos = (sel[..., None] * SEL_BLOCK + jnp.arange(SEL_BLOCK)).reshape(b, N_KV_GROUPS, Q_BLOCK, n_sel * SEL_BLOCK)
        ss = jnp.einsum('bqghd,bgqkd->bghqk', qc, ks).astype(jnp.float32) * scale
        p_s = masked_softmax(ss, (kpos <= t[None, None, :, None])[:, :, None])
        o_s = jnp.einsum('bghqk,bgqkd->bqghd', p_s.astype(vs.dtype), vs)
        kw = lax.dynamic_slice_in_dim(kwp, t0, WINDOW + Q_BLOCK, axis=1)
        vw = lax.dynamic_slice_in_dim(vwp, t0, WINDOW + Q_BLOCK, axis=1)
        spos = t0 - WINDOW + jnp.arange(WINDOW + Q_BLOCK)
        diff = t[:, None] - spos[None, :]
        mask_w = (diff >= 0) & (diff < WINDOW) & (spos[None, :] >= 0)
        sw = jnp.einsum('bqghd,bkgd->bghqk', qc, kw).astype(jnp.float32) * scale
        p_w = masked_softmax(sw, mask_w)
        o_w = jnp.einsum('bghqk,bkgd->bqghd', p_w.astype(vw.dtype), vw)
        out = gc[..., 0:1] * o_c + gc[..., 1:2] * o_s + gc[..., 2:3] * o_w
        return out.reshape(b, Q_BLOCK, ATTN_WIDTH)

    out = lax.map(query_block, jnp.arange(n_qb))
    return out.transpose(1, 0, 2, 3).reshape(b, s, ATTN_WIDTH)


def setup_inputs(seed: int = 0) -> dict:
    key = jax.random.key(seed)
    ks = jax.random.split(key, 24)
    L = DEPTH
    nrm = lambda k, shape, scale: jax.random.normal(k, shape, jnp.float32) * scale
    x = jax.random.normal(ks[0], (BATCH, SEQ, D_MODEL), jnp.float32)
    positions = (jnp.arange(SEQ, dtype=jnp.int32)[None, :] + jax.random.randint(ks[1], (BATCH, 1), 0, 1024, dtype=jnp.int32)).astype(jnp.int32)
    return {
        'x': x,
        'positions': positions,
        'norm1_g': 1.0 + nrm(ks[2], (L, D_MODEL), 0.02),
        'w_in': nrm(ks[3], (L, D_MODEL, IN_COLS), D_MODEL ** -0.5),
        'conv_a_w': nrm(ks[4], (L, CONV_K, CONV_WIDTH_A), CONV_K ** -0.5),
        'w_a_out': nrm(ks[5], (L, CONV_WIDTH_A, D_MODEL), CONV_WIDTH_A ** -0.5),
        'q_norm_g': 1.0 + nrm(ks[6], (L, HEAD_DIM), 0.02),
        'k_norm_g': 1.0 + nrm(ks[7], (L, N_NSA_BRANCH, HEAD_DIM), 0.02),
        'cmp_k_pe': nrm(ks[8], (L, CMP_BLOCK, HEAD_DIM), 0.1),
        'cmp_k_w1': nrm(ks[9], (L, CMP_BLOCK * HEAD_DIM, HEAD_DIM), (CMP_BLOCK * HEAD_DIM) ** -0.5),
        'cmp_k_w2': nrm(ks[10], (L, HEAD_DIM, HEAD_DIM), HEAD_DIM ** -0.5),
        'cmp_v_pe': nrm(ks[11], (L, CMP_BLOCK, HEAD_DIM), 0.1),
        'cmp_v_w1': nrm(ks[12], (L, CMP_BLOCK * HEAD_DIM, HEAD_DIM), (CMP_BLOCK * HEAD_DIM) ** -0.5),
        'cmp_v_w2': nrm(ks[13], (L, HEAD_DIM, HEAD_DIM), HEAD_DIM ** -0.5),
        'w_b_out': nrm(ks[14], (L, ATTN_WIDTH, D_MODEL), ATTN_WIDTH ** -0.5),
        'w_o': nrm(ks[15], (L, D_MODEL, D_MODEL), D_MODEL ** -0.5),
        'norm2_g': 1.0 + nrm(ks[16], (L, D_MODEL), 0.02),
        'w_ffn_in': nrm(ks[17], (L, D_MODEL, 2 * D_FF), D_MODEL ** -0.5),
        'ffn_conv_w': nrm(ks[18], (L, CONV_K, D_FF), CONV_K ** -0.5),
        'ffn_conv_b': nrm(ks[19], (L, D_FF), 0.02),
        'w_ffn_out': nrm(ks[20], (L, D_FF, D_MODEL), D_FF ** -0.5),
    }


def reference(x, positions, norm1_g, w_in, conv_a_w, w_a_out, q_norm_g, k_norm_g, cmp_k_pe, cmp_k_w1, cmp_k_w2, cmp_v_pe, cmp_v_w1, cmp_v_w2, w_b_out, w_o, norm2_g, w_ffn_in, ffn_conv_w, ffn_conv_b, w_ffn_out):
    b, s, _ = x.shape
    cuts = list(np.cumsum(SPLIT_SIZES)[:-1].tolist())
    for l in range(DEPTH):
        h = rmsnorm(x, norm1_g[l])
        proj = h @ w_in[l]
        a_b, a_c, a_x, q, kc, vc, ksl, vsl, kwn, vwn, g_nsa, g_merge = jnp.split(proj, cuts, axis=-1)
        y_a = a_b * causal_dwconv(a_c * a_x, conv_a_w[l])
        q = rope(rmsnorm(q.reshape(b, s, N_HEADS, HEAD_DIM), q_norm_g[l]), positions)
        kv_shape = (b, s, N_KV_GROUPS, HEAD_DIM)
        k_cmp = rmsnorm(compress(kc.reshape(kv_shape), cmp_k_pe[l], cmp_k_w1[l], cmp_k_w2[l]), k_norm_g[l, 0])
        v_cmp = compress(vc.reshape(kv_shape), cmp_v_pe[l], cmp_v_w1[l], cmp_v_w2[l])
        k_sel = rope(rmsnorm(ksl.reshape(kv_shape), k_norm_g[l, 1]), positions)
        k_win = rope(rmsnorm(kwn.reshape(kv_shape), k_norm_g[l, 2]), positions)
        gates = jax.nn.sigmoid(g_nsa).reshape(b, s, N_HEADS, N_NSA_BRANCH)
        y_b = nsa(q, k_cmp, v_cmp, k_sel, vsl.reshape(kv_shape), k_win, vwn.reshape(kv_shape), gates)
        gm = jax.nn.sigmoid(g_merge)
        mix = gm[..., :D_MODEL] * (y_a @ w_a_out[l]) + gm[..., D_MODEL:] * (y_b @ w_b_out[l])
        x = x + mix @ w_o[l]
        h = rmsnorm(x, norm2_g[l])
        gu = h @ w_ffn_in[l]
        g = causal_dwconv(gu[..., :D_FF], ffn_conv_w[l]) + ffn_conv_b[l]
        x = x + (jax.nn.silu(g) * gu[..., D_FF:]) @ w_ffn_out[l]
    return x
```

```cpp
#include <hip/hip_runtime.h>
#include <hip/hip_bf16.h>
#include <cstdio>
#include <cstdint>
#include <cmath>
constexpr int NBATCH = 8, SEQ = 4096, T = NBATCH * SEQ, DM = 1024, INCOLS = 4888, NIN = 5120, DFF = 2816, NFF = 2 * DFF, CW = 512;
constexpr size_t MiB = 1u << 20;
constexpr size_t WS_CTL = 0, CTL_ZERO_BYTES = 1 * MiB;
constexpr size_t WS_CB = 1 * MiB;
constexpr size_t WS_CMPK = 1 * MiB + 65536, WS_CMPV = WS_CMPK + 524288;
constexpr size_t WS_SSQ = 3 * MiB;
constexpr size_t WS_GNSA = 5 * MiB;
constexpr size_t WS_WIN = 8 * MiB, WS_WA = 18 * MiB, WS_WB = 19 * MiB, WS_WO = 20 * MiB, WS_WFF = 22 * MiB, WS_WDN = 33 * MiB, WS_W1K = 39 * MiB, WS_W1V = 39 * MiB + 262144;
constexpr size_t WS_CS = 40 * MiB;
constexpr size_t WS_TAIL = 48 * MiB, WS_HEADP = 51 * MiB, WS_HEADU = 54 * MiB;
constexpr size_t WS_RS = 57 * MiB;
constexpr size_t WS_X1B = 64 * MiB;
constexpr size_t WS_H1 = 160 * MiB, WS_YAB = 160 * MiB;
constexpr size_t WS_AB = 224 * MiB, WS_ACX = 256 * MiB;
constexpr size_t WS_Q = 288 * MiB, WS_KC = 320 * MiB, WS_VC = 328 * MiB, WS_KS = 336 * MiB, WS_VS = 344 * MiB, WS_KW = 352 * MiB, WS_VW = 360 * MiB, WS_MIX = 288 * MiB;
constexpr size_t WS_GM = 370 * MiB;
constexpr size_t WS_ACT = 160 * MiB, WS_END = 512 * MiB;
constexpr int CW_BAR = 4096;
namespace pg8 {
#define PG8_LAS __attribute__((address_space(3)))
typedef unsigned short bf16_t;
typedef short bf16x8 __attribute__((ext_vector_type(8)));
typedef float f32x4 __attribute__((ext_vector_type(4)));
typedef unsigned u32x4 __attribute__((ext_vector_type(4)));
constexpr int BM = 256, BK = 64, HALF = 128, HTB = HALF * BK * 2  , STAGE_BYTES = 8 * HTB, NXCD = 8, WGM = 2;

__host__ __device__ __forceinline__ int lds_byte(int r, int c) { const int st = (r >> 4) * 2 + (c >> 5), rr = r & 15, cc = c & 31, ob = rr * 64 + cc * 2; return st * 1024 + (ob ^ (((ob >> 9) & 1) << 5)); }
__host__ __device__ __forceinline__ void stage_rc(int b, int& R, int& C) { const int st = b / 1024, sb = b % 1024, swz = sb ^ (((sb >> 9) & 1) << 5); R = (st >> 1) * 16 + swz / 64; C = (st & 1) * 32 + (swz % 64) / 2; }
__host__ __device__ __forceinline__ int perm32(int rho) { const int n = rho >> 4, i = rho & 15; return 8 * (i >> 2) + 4 * n + (i & 3); }

struct Unit { int pm, pn; };
struct Gemm { const bf16_t* A; const bf16_t* Bt; int M, N, K; };

struct StaticOrder {
    int nM, nN, nwg, G, c;
    __host__ __device__ void init(int M, int N, int G_, int c_) { nM = M / BM; nN = N / BM; nwg = nM * nN; G = G_; c = c_; }
    __host__ __device__ bool next(int i, Unit& u) const {
        const long L = (long)i * G + c; if (L >= nwg) return false;
        int wgid = (int)L; { const int q = nwg / NXCD, r = nwg % NXCD, xcd = wgid % NXCD, off = wgid / NXCD; wgid = (xcd < r ? xcd * (q + 1) : r * (q + 1) + (xcd - r) * q) + off; }
        const int nig = WGM * nN, gid = wgid / nig, fm = gid * WGM, gsz = (nM - fm) < WGM ? (nM - fm) : WGM;
        u.pm = fm + ((wgid % nig) % gsz); u.pn = (wgid % nig) / gsz; return true;
    }
    __device__ __forceinline__ void a_ready(const Unit&) const {}
    __device__ __forceinline__ void done(const Unit&) const {}
};

typedef float f32x2_cv __attribute__((ext_vector_type(2))); typedef __bf16 bf16x2_cv __attribute__((ext_vector_type(2)));
__device__ __forceinline__ unsigned cvt_pk_bf16(float lo, float hi) { f32x2_cv v = {lo, hi}; bf16x2_cv b = __builtin_convertvector(v, bf16x2_cv); return __builtin_bit_cast(unsigned, b); }
typedef float f32x2 __attribute__((ext_vector_type(2)));
constexpr float EPSN = 1e-6f;
constexpr float QC2 = 0.125f * 1.4426950408889634f;
__device__ __forceinline__ u32x4 pack8(const f32x4 a, const f32x4 b) { u32x4 w; w.x = cvt_pk_bf16(a[0], a[1]); w.y = cvt_pk_bf16(a[2], a[3]); w.z = cvt_pk_bf16(b[0], b[1]); w.w = cvt_pk_bf16(b[2], b[3]); return w; }
__device__ __forceinline__ void unpack8(const u32x4 w, f32x4& a, f32x4& b) {
    a[0] = __uint_as_float(w.x << 16); a[1] = __uint_as_float(w.x & 0xffff0000u); a[2] = __uint_as_float(w.y << 16); a[3] = __uint_as_float(w.y & 0xffff0000u);
    b[0] = __uint_as_float(w.z << 16); b[1] = __uint_as_float(w.z & 0xffff0000u); b[2] = __uint_as_float(w.w << 16); b[3] = __uint_as_float(w.w & 0xffff0000u); }
__device__ __forceinline__ float sigm(float x) { return __builtin_amdgcn_rcpf(1.0f + __builtin_amdgcn_exp2f(-1.4426950408889634f * x)); }
__device__ __forceinline__ f32x4 sigm4(const f32x4 v) { return (f32x4){sigm(v[0]), sigm(v[1]), sigm(v[2]), sigm(v[3])}; }
__device__ __forceinline__ float dot4(const f32x4 v) { return (v[0] * v[0] + v[1] * v[1]) + (v[2] * v[2] + v[3] * v[3]); }

struct EpiIn {
    static constexpr bool PERM = true, AFTER_DRAIN = false, PREFETCH = false, B_NT = true; static constexpr int MID_T = -1;
    unsigned char* ws; const float* qg; const float* kg;
    __device__ __forceinline__ void operator()(const f32x4 (&acc)[2][2][4][2], const Unit& u, int wr, int wc, int fr, int fq) const {
        const int pn = u.pn; const int row0 = u.pm * BM + wr * 64 + fr;
        bf16_t* const AB = (bf16_t*)(ws + WS_AB); bf16_t* const ACX = (bf16_t*)(ws + WS_ACX); bf16_t* const Q = (bf16_t*)(ws + WS_Q);
        float* const GNSA = (float*)(ws + WS_GNSA); const float* const CS = (const float*)(ws + WS_CS);
        if (pn < 2) {
#pragma unroll
            for (int ai = 0; ai < 2; ++ai)
#pragma unroll
                for (int m = 0; m < 4; ++m) { const size_t row = (size_t)(row0 + ai * HALF + m * 16);
#pragma unroll
                    for (int bj = 0; bj < 2; ++bj) __builtin_nontemporal_store(pack8(acc[ai][bj][m][0], acc[ai][bj][m][1]), (u32x4*)(AB + row * 512 + pn * 256 + bj * HALF + wc * 32 + fq * 8)); }
        } else if (pn < 6) {
            const int ch = (pn - 2) * 128 + wc * 32 + fq * 8;
#pragma unroll
            for (int ai = 0; ai < 2; ++ai)
#pragma unroll
                for (int m = 0; m < 4; ++m) { const size_t row = (size_t)(row0 + ai * HALF + m * 16);
                    __builtin_nontemporal_store(pack8(acc[ai][0][m][0] * acc[ai][1][m][0], acc[ai][0][m][1] * acc[ai][1][m][1]), (u32x4*)(ACX + row * 512 + ch)); }
        } else if (pn < 9) {
            const bool isq = pn < 8;
            const float* gam = isq ? qg : (kg + (wc < 2 ? 64 : 128));
            const f32x4 g00 = *(const f32x4*)(gam + 8 * fq), g01 = *(const f32x4*)(gam + 8 * fq + 4), g10 = *(const f32x4*)(gam + 32 + 8 * fq), g11 = *(const f32x4*)(gam + 32 + 8 * fq + 4);
            const float osc = isq ? QC2 : 1.0f;
#pragma unroll
            for (int ai = 0; ai < 2; ++ai)
#pragma unroll
                for (int m = 0; m < 4; ++m) { const int row = row0 + ai * HALF + m * 16;
                    const f32x4 v00 = acc[ai][0][m][0], v01 = acc[ai][0][m][1], v10 = acc[ai][1][m][0], v11 = acc[ai][1][m][1];
                    float ss = (dot4(v00) + dot4(v01)) + (dot4(v10) + dot4(v11));
                    ss += __shfl_xor(ss, 16); ss += __shfl_xor(ss, 32);
                    const float r = 1.0f / sqrtf(ss * (1.0f / 64.0f) + EPSN);
                    const f32x4 x1a = v00 * r * g00, x1b = v01 * r * g01, x2a = v10 * r * g10, x2b = v11 * r * g11;
                    const float* cs = CS + (size_t)row * 64 + 8 * fq;
                    const f32x4 ca = *(const f32x4*)(cs), cb = *(const f32x4*)(cs + 4), sa = *(const f32x4*)(cs + 32), sb = *(const f32x4*)(cs + 36);
                    const f32x4 o1a = (x1a * ca - x2a * sa) * osc, o1b = (x1b * cb - x2b * sb) * osc, o2a = (x2a * ca + x1a * sa) * osc, o2b = (x2b * cb + x1b * sb) * osc;
                    bf16_t* dst;
                    if (isq) dst = Q + (size_t)row * 512 + (4 * (pn - 6) + wc) * 64;
                    else dst = (bf16_t*)(ws + (wc < 2 ? WS_KS : WS_KW)) + ((size_t)((row >> 12) * 2 + (wc & 1)) * 4096 + (row & 4095)) * 64;
                    *(u32x4*)(dst + 8 * fq) = pack8(o1a, o1b); *(u32x4*)(dst + 32 + 8 * fq) = pack8(o2a, o2b); }
        } else if (pn < 11) {
            bf16_t* base = (bf16_t*)(ws + ((pn == 9) ? (wc < 2 ? WS_KC : WS_VC) : (wc < 2 ? WS_VS : WS_VW)));
#pragma unroll
            for (int ai = 0; ai < 2; ++ai)
#pragma unroll
                for (int m = 0; m < 4; ++m) { const int row = row0 + ai * HALF + m * 16;
                    bf16_t* dst = base + ((size_t)((row >> 12) * 2 + (wc & 1)) * 4096 + (row & 4095)) * 64;
                    *(u32x4*)(dst + 8 * fq) = pack8(acc[ai][0][m][0], acc[ai][0][m][1]); *(u32x4*)(dst + 32 + 8 * fq) = pack8(acc[ai][1][m][0], acc[ai][1][m][1]); }
        } else if (pn == 11) {
            if (wc == 0 && fq < 3) {
#pragma unroll
                for (int ai = 0; ai < 2; ++ai)
#pragma unroll
                    for (int m = 0; m < 4; ++m) { const size_t row = (size_t)(row0 + ai * HALF + m * 16);
                        *(f32x4*)(GNSA + row * 24 + 8 * fq) = sigm4(acc[ai][0][m][0]); *(f32x4*)(GNSA + row * 24 + 8 * fq + 4) = sigm4(acc[ai][0][m][1]); } }
        } else {
            bf16_t* const GM = (bf16_t*)(ws + WS_GM);
#pragma unroll
            for (int ai = 0; ai < 2; ++ai)
#pragma unroll
                for (int m = 0; m < 4; ++m) { const size_t row = (size_t)(row0 + ai * HALF + m * 16);
#pragma unroll
                    for (int bj = 0; bj < 2; ++bj) __builtin_nontemporal_store(pack8(sigm4(acc[ai][bj][m][0]), sigm4(acc[ai][bj][m][1])), (u32x4*)(GM + row * 2048 + (pn - 12) * 256 + bj * HALF + wc * 32 + fq * 8)); }
        }
    }
};
template <bool ADD> struct EpiGate {
    static constexpr bool PERM = true, AFTER_DRAIN = false, PREFETCH = false, B_NT = false; static constexpr int MID_T = -1;
    const bf16_t* GM; int goff; const bf16_t* ADDSRC; bf16_t* O;
    __device__ __forceinline__ void operator()(const f32x4 (&acc)[2][2][4][2], const Unit& u, int wr, int wc, int fr, int fq) const {
        const int row0 = u.pm * BM + wr * 64 + fr;
#pragma unroll
        for (int ai = 0; ai < 2; ++ai)
#pragma unroll
            for (int m = 0; m < 4; ++m) { const size_t row = (size_t)(row0 + ai * HALF + m * 16);
#pragma unroll
                for (int bj = 0; bj < 2; ++bj) { const int col = u.pn * BM + bj * HALF + wc * 32 + fq * 8;
                    f32x4 ga, gb; unpack8(*(const u32x4*)(GM + row * 2048 + goff + col), ga, gb);
                    f32x4 ra = ga * acc[ai][bj][m][0], rb = gb * acc[ai][bj][m][1];
                    if (ADD) { f32x4 aa, ab; unpack8(*(const u32x4*)(ADDSRC + row * 1024 + col), aa, ab); ra += aa; rb += ab; }
                    *(u32x4*)(O + row * 1024 + col) = pack8(ra, rb); } }
    }
};
struct EpiMerge {
    static constexpr bool PERM = true, AFTER_DRAIN = false, PREFETCH = false, B_NT = false; static constexpr int MID_T = 8;
    const bf16_t* GM; bf16_t* O;
    __device__ __forceinline__ void mid(f32x4 (&acc)[2][2][4][2], const Unit& u, int wr, int wc, int fr_in, int fq_in) const {
        int fr = fr_in, fq = fq_in; asm volatile("" : "+v"(fr), "+v"(fq));
        const bf16_t* gbase = GM + (size_t)u.pm * BM * 2048 + u.pn * BM;
#pragma unroll
        for (int ai = 0; ai < 2; ++ai)
#pragma unroll
            for (int m = 0; m < 4; ++m)
#pragma unroll
                for (int bj = 0; bj < 2; ++bj) { const unsigned off = (unsigned)((wr * 64 + ai * HALF + m * 16 + fr) * 2048 + bj * HALF + wc * 32 + fq * 8);
                    f32x4 a0, a1, b0, b1; unpack8(*(const u32x4*)(gbase + off), a0, a1); unpack8(*(const u32x4*)(gbase + off + 1024), b0, b1);
#pragma unroll
                    for (int i = 0; i < 4; ++i) { acc[ai][bj][m][0][i] *= b0[i] * __builtin_amdgcn_rcpf(fmaxf(a0[i], 1e-30f)); acc[ai][bj][m][1][i] *= b1[i] * __builtin_amdgcn_rcpf(fmaxf(a1[i], 1e-30f)); } }
    }
    __device__ __forceinline__ void operator()(const f32x4 (&acc)[2][2][4][2], const Unit& u, int wr, int wc, int fr_in, int fq_in) const {
        int fr = fr_in, fq = fq_in; asm volatile("" : "+v"(fr), "+v"(fq));
        const bf16_t* gbase = GM + (size_t)u.pm * BM * 2048 + u.pn * BM; bf16_t* obase = O + (size_t)u.pm * BM * 1024 + u.pn * BM;
#pragma unroll
        for (int ai = 0; ai < 2; ++ai)
#pragma unroll
            for (int m = 0; m < 4; ++m)
#pragma unroll
                for (int bj = 0; bj < 2; ++bj) { const unsigned rl = (unsigned)(wr * 64 + ai * HALF + m * 16 + fr), cl = (unsigned)(bj * HALF + wc * 32 + fq * 8);
                    f32x4 a0, a1; unpack8(*(const u32x4*)(gbase + rl * 2048 + cl), a0, a1);
                    __builtin_nontemporal_store(pack8(acc[ai][bj][m][0] * a0, acc[ai][bj][m][1] * a1), (u32x4*)(obase + rl * 1024 + cl)); }
    }
};
struct EpiWO {
    static constexpr bool PERM = true, AFTER_DRAIN = false, PREFETCH = false, B_NT = false; static constexpr int MID_T = -1;
    const float* X; bf16_t* X1B; float* SSQ;
    __device__ __forceinline__ void operator()(const f32x4 (&acc)[2][2][4][2], const Unit& u, int wr, int wc, int fr, int fq) const {
        const int row0 = u.pm * BM + wr * 64 + fr;
#pragma unroll
        for (int ai = 0; ai < 2; ++ai)
#pragma unroll
            for (int m = 0; m < 4; ++m) { const size_t row = (size_t)(row0 + ai * HALF + m * 16); float ss = 0.f;
#pragma unroll
                for (int bj = 0; bj < 2; ++bj) { const int col = u.pn * BM + bj * HALF + wc * 32 + fq * 8;
                    const f32x4 ya = *(const f32x4*)(X + row * 1024 + col) + acc[ai][bj][m][0], yb = *(const f32x4*)(X + row * 1024 + col + 4) + acc[ai][bj][m][1];
                    *(u32x4*)(X1B + row * 1024 + col) = pack8(ya, yb); ss += dot4(ya) + dot4(yb); }
                ss += __shfl_xor(ss, 16); ss += __shfl_xor(ss, 32);
                if (fq == 0) SSQ[row * 16 + u.pn * 4 + wc] = ss; }
    }
};
__device__ __forceinline__ f32x4 dpp_ror1(const f32x4 v) { f32x4 r;
#pragma unroll
    for (int i = 0; i < 4; ++i) r[i] = __int_as_float(__builtin_amdgcn_mov_dpp(__float_as_int(v[i]), 0x121, 0xF, 0xF, false)); return r; }
__device__ __forceinline__ f32x4 dpp_ror2(const f32x4 v) { f32x4 r;
#pragma unroll
    for (int i = 0; i < 4; ++i) r[i] = __int_as_float(__builtin_amdgcn_mov_dpp(__float_as_int(v[i]), 0x122, 0xF, 0xF, false)); return r; }
__device__ __forceinline__ f32x4 silu4(const f32x4 v) { return (f32x4){v[0] * sigm(v[0]), v[1] * sigm(v[1]), v[2] * sigm(v[2]), v[3] * sigm(v[3])}; }
struct EpiFF1 {
    static constexpr bool PERM = true, AFTER_DRAIN = false, PREFETCH = true, B_NT = true; static constexpr int MID_T = -1;
    const float* RS; bf16_t* ACT; float* TAIL; float* HEADP; float* HEADU; const float* cw; const float* cb; PG8_LAS float* hl;
    __device__ __forceinline__ void pre(const Unit& u, int par, int wid, int lane_in) const {
        int lane = lane_in; asm volatile("" : "+v"(lane));
        if (wid < 4) __builtin_amdgcn_global_load_lds((const unsigned*)(RS + (size_t)u.pm * BM + wid * 64 + lane), (PG8_LAS unsigned*)(hl + 1024 + par * 256 + wid * 64), 4, 0, 0);
        const int arr = wid >> 1; const float* src = (arr < 3 ? cw + arr * 2816 : cb) + u.pn * 128 + (wid & 1) * 64 + lane;
        __builtin_amdgcn_global_load_lds((const unsigned*)src, (PG8_LAS unsigned*)(hl + 1536 + par * 512 + wid * 64), 4, 0, 0);
    }
    __device__ __forceinline__ void ep(const f32x4 (&acc)[2][2][4][2], const Unit& u, int wr, int wc, int fr_in, int fq_in, int par) const {
        int fr = fr_in, fq = fq_in; asm volatile("" : "+v"(fr), "+v"(fq));
        const int pm = __builtin_amdgcn_readfirstlane(u.pm), pn = __builtin_amdgcn_readfirstlane(u.pn);
        const int chl = wc * 32 + fq * 8, ch = pn * 128 + chl;
        const PG8_LAS float* rl = hl + 1024 + par * 256 + wr * 64 + fr;
        const PG8_LAS float* cl = hl + 1536 + par * 512 + chl;
        if (fr >= 14) {
#pragma unroll
            for (int ai = 0; ai < 2; ++ai) { PG8_LAS float* h = hl + ((ai * 2 + wr) * 2 + (fr - 14)) * 128 + chl; const float r3 = rl[ai * HALF + 48];
                const f32x4 ga = acc[ai][0][3][0] * r3, gb = acc[ai][0][3][1] * r3;
                *(PG8_LAS f32x4*)h = ga; *(PG8_LAS f32x4*)(h + 4) = gb;
                if (ai == 1 && wr == 1) { float* tp = TAIL + ((size_t)pm * 2 + (fr - 14)) * 2816 + ch; *(f32x4*)tp = ga; *(f32x4*)(tp + 4) = gb; } } }
        asm volatile("s_waitcnt lgkmcnt(0)\n\ts_barrier" ::: "memory");
        char* tile_act; { const unsigned long long v = (unsigned long long)(ACT + (size_t)pm * BM * 2816 + pn * 128);
            tile_act = (char*)(((unsigned long long)(unsigned)__builtin_amdgcn_readfirstlane((int)(v >> 32)) << 32) | (unsigned)__builtin_amdgcn_readfirstlane((int)(unsigned)v)); }
        char* tile_hp = (char*)(HEADP + (size_t)pm * 2 * 2816 + pn * 128); char* tile_hu = (char*)(HEADU + (size_t)pm * 2 * 2816 + pn * 128);
        const unsigned vbase = (unsigned)((wr * 64 + fr) * 2816 + chl) * 2u;
#pragma unroll
        for (int ai = 0; ai < 2; ++ai) {
            const int blk = ai * 2 + wr;
            f32x4 c1[2], c2[2];
#pragma unroll
            for (int n = 0; n < 2; ++n) { f32x4 h0 = (f32x4){0.f, 0.f, 0.f, 0.f}, h1 = h0;
                if (blk > 0) { h0 = *(const PG8_LAS f32x4*)(hl + ((blk - 1) * 2 + 0) * 128 + chl + 4 * n); h1 = *(const PG8_LAS f32x4*)(hl + ((blk - 1) * 2 + 1) * 128 + chl + 4 * n); }
                c1[n] = h1; c2[n] = (fr == 0) ? h0 : h1; }
#pragma unroll
            for (int m = 0; m < 4; ++m) {
                const unsigned voff = vbase + (unsigned)((ai * HALF + m * 16) * 2816 * 2);
                const float rsv = rl[ai * HALF + m * 16], rsu = rsv * 0.4804530139182014f;
                f32x4 o;
#pragma unroll
                for (int n = 0; n < 2; ++n) {
                    const f32x4 w0 = *(const PG8_LAS f32x4*)(cl + 4 * n), w1 = *(const PG8_LAS f32x4*)(cl + 128 + 4 * n), w2 = *(const PG8_LAS f32x4*)(cl + 256 + 4 * n), bb = *(const PG8_LAS f32x4*)(cl + 384 + 4 * n) * -1.4426950408889634f;
                    const f32x4 cur = acc[ai][0][m][n] * rsv;
                    const f32x4 r1 = dpp_ror1(cur), r2 = dpp_ror2(cur);
                    f32x4 p1 = r1, p2 = r2;
                    if (fr == 0) p1 = c1[n];
                    if (fr < 2) p2 = c2[n];
                    c1[n] = r1; c2[n] = r2;
                    const f32x4 pre = (w0 * p2 + w1 * p1) + (w2 * cur + bb);
                    const f32x4 uv = acc[ai][1][m][n] * rsu;
                    f32x4 sg;
#pragma unroll
                    for (int i = 0; i < 4; ++i) sg[i] = __builtin_amdgcn_rcpf(1.0f + __builtin_amdgcn_exp2f(pre[i]));
                    const f32x4 res = (pre * sg) * uv;
                    o[2 * n] = __uint_as_float(cvt_pk_bf16(res[0], res[1])); o[2 * n + 1] = __uint_as_float(cvt_pk_bf16(res[2], res[3]));
                    if (blk == 0 && m == 0 && fr < 2) { const unsigned hoff = (unsigned)(fr * 2816 + chl + 4 * n) * 4u; *(f32x4*)(tile_hp + hoff) = pre; *(f32x4*)(tile_hu + hoff) = uv; } }
                asm volatile("global_store_dwordx4 %0, %1, %2 nt" :: "v"(voff), "v"(o), "s"(tile_act) : "memory");
                __builtin_amdgcn_sched_barrier(0); }
        }
    }
};
struct EpiFF2 {
    static constexpr bool PERM = true, AFTER_DRAIN = false, PREFETCH = false, B_NT = false; static constexpr int MID_T = -1;
    const bf16_t* X1B; float* OUT;
    __device__ __forceinline__ void operator()(const f32x4 (&acc)[2][2][4][2], const Unit& u, int wr, int wc, int fr, int fq) const {
        const int row0 = u.pm * BM + wr * 64 + fr;
#pragma unroll
        for (int ai = 0; ai < 2; ++ai)
#pragma unroll
            for (int m = 0; m < 4; ++m) { const size_t row = (size_t)(row0 + ai * HALF + m * 16);
#pragma unroll
                for (int bj = 0; bj < 2; ++bj) { const size_t off = row * 1024 + u.pn * BM + bj * HALF + wc * 32 + fq * 8;
                    f32x4 xa, xb; unpack8(*(const u32x4*)(X1B + off), xa, xb);
                    __builtin_nontemporal_store(xa + acc[ai][bj][m][0], (f32x4*)(OUT + off)); __builtin_nontemporal_store(xb + acc[ai][bj][m][1], (f32x4*)(OUT + off + 4)); } }
    }
};
template <class Epi, class Sched, bool ALIGN_EPI = false, bool SP2 = false>
__device__ __forceinline__ void gemm_phase(PG8_LAS unsigned char* lds, const Gemm g, const Sched& S, const Epi& E) {
    const int tid = threadIdx.x, wid = __builtin_amdgcn_readfirstlane(tid >> 6), lane = tid & 63, wr = wid >> 2, wc = wid & 3, fr = lane & 15, fq = lane >> 4;
    const int K = g.K, nt = K / BK;
    unsigned voffA[2], voffB[2];
#pragma unroll
    for (int i = 0; i < 2; ++i) { int R, C; stage_rc(tid * 16 + i * 8192, R, C); const int Rb = Epi::PERM ? ((R & ~31) + perm32(R & 31)) : R;
        voffA[i] = (unsigned)(R * K + C) * 2u; voffB[i] = (unsigned)(Rb * K + C) * 2u; }
    const size_t kstep = (size_t)(BK * 2);
    const size_t hstep = (size_t)HALF * K * 2;
    const size_t tstep = 2 * hstep;
    const unsigned ldsw = (unsigned)wid * 1024u;
    const int aoff = lds_byte(wr * 64 + fr, fq * 8), boff = lds_byte(wc * 32 + fr, fq * 8);
#define PG8_SA(b, h) (((b) * 2 + (h)) * HTB)
#define PG8_SB(b, h) ((4 + (b) * 2 + (h)) * HTB)
#define PG8_STAGE_(bufoff, gbase, voff, AUX) do { _Pragma("unroll") for (int _i = 0; _i < 2; ++_i) \
        __builtin_amdgcn_global_load_lds((const unsigned*)((const char*)(gbase) + (voff)[_i]), (PG8_LAS unsigned*)(lds + (bufoff) + ldsw + _i * 8192), 16, 0, AUX); } while (0)
#define PG8_STAGE(bufoff, gbase, voff) do { if constexpr (Epi::B_NT && ((bufoff) >= 4 * HTB)) PG8_STAGE_(bufoff, gbase, voff, 2); else PG8_STAGE_(bufoff, gbase, voff, 0); } while (0)
#define PG8_LDA(dst, b, h) do { _Pragma("unroll") for (int m = 0; m < 4; ++m) _Pragma("unroll") for (int k = 0; k < 2; ++k) dst[m][k] = *(const PG8_LAS bf16x8*)(lds + PG8_SA(b, h) + aoff + m * 2048 + k * 1024); } while (0)
#define PG8_LDB(dst, b, h) do { _Pragma("unroll") for (int n = 0; n < 2; ++n) _Pragma("unroll") for (int k = 0; k < 2; ++k) dst[n][k] = *(const PG8_LAS bf16x8*)(lds + PG8_SB(b, h) + boff + n * 2048 + k * 1024); } while (0)
#define PG8_MMA(ai, bj, At, Bt) do { __builtin_amdgcn_s_setprio(1); _Pragma("unroll") for (int m = 0; m < 4; ++m) _Pragma("unroll") for (int n = 0; n < 2; ++n) _Pragma("unroll") for (int k = 0; k < 2; ++k) \
        acc[ai][bj][m][n] = __builtin_amdgcn_mfma_f32_16x16x32_bf16(Bt[n][k], At[m][k], acc[ai][bj][m][n], 0, 0, 0); __builtin_amdgcn_s_setprio(0); } while (0)
#define PG8_WAIT_V(n) asm volatile("s_waitcnt vmcnt(" #n ")" ::: "memory")
#define PG8_WAIT_L(n) asm volatile("s_waitcnt lgkmcnt(" #n ")" ::: "memory")
#define PG8_BAR __builtin_amdgcn_s_barrier()
#define PG8_SCHED __builtin_amdgcn_sched_barrier(0)
    Unit cur, nxt; int ui = 0;
    if (!S.next(0, cur)) return;
    f32x4 acc[2][2][4][2];
#pragma unroll
    for (int a = 0; a < 2; ++a)
#pragma unroll
        for (int b = 0; b < 2; ++b)
#pragma unroll
            for (int m = 0; m < 4; ++m)
#pragma unroll
                for (int n = 0; n < 2; ++n) acc[a][b][m][n] = (f32x4){0.f, 0.f, 0.f, 0.f};
    bf16x8 At[4][2], B0[2][2], B1[2][2];
    const char* cA = (const char*)g.A + (size_t)cur.pm * tstep; const char* cB = (const char*)g.Bt + (size_t)cur.pn * tstep;
    S.a_ready(cur);
    if constexpr (Epi::PREFETCH) E.pre(cur, 0, wid, lane);
    if constexpr (SP2) {
        PG8_STAGE(PG8_SB(0, 0), cB, voffB); PG8_STAGE(PG8_SB(0, 1), cB + hstep, voffB); PG8_STAGE(PG8_SA(0, 0), cA, voffA); PG8_STAGE(PG8_SA(0, 1), cA + hstep, voffA);
        if (wr == 1) PG8_BAR;
        PG8_WAIT_V(2); PG8_BAR;
        PG8_STAGE(PG8_SB(1, 0), cB + kstep, voffB); PG8_STAGE(PG8_SA(1, 0), cA + kstep, voffA); PG8_STAGE(PG8_SB(1, 1), cB + hstep + kstep, voffB);
        PG8_WAIT_V(6); PG8_BAR;
    } else {
        PG8_STAGE(PG8_SB(0, 0), cB, voffB); PG8_STAGE(PG8_SA(0, 0), cA, voffA); PG8_STAGE(PG8_SB(0, 1), cB + hstep, voffB); PG8_STAGE(PG8_SA(0, 1), cA + hstep, voffA);
        if (wr == 1) PG8_BAR;
        PG8_WAIT_V(4); PG8_BAR;
        PG8_STAGE(PG8_SB(1, 0), cB + kstep, voffB); PG8_STAGE(PG8_SA(1, 0), cA + kstep, voffA); PG8_STAGE(PG8_SB(1, 1), cB + hstep + kstep, voffB);
        PG8_WAIT_V(6); PG8_BAR;
    }
    for (;;) {
        const bool has_next = S.next(ui + 1, nxt);
        const char* nA = has_next ? (const char*)g.A + (size_t)nxt.pm * tstep : cA; const char* nB = has_next ? (const char*)g.Bt + (size_t)nxt.pn * tstep : cB;
        for (int t = 0; t < nt; t += 2) {
            if constexpr (Epi::MID_T >= 0) { if (t == Epi::MID_T) E.mid(acc, cur, wr, wc, fr, fq); }
            const bool last = (t == nt - 2);
            const char* a1 = cA + (size_t)(t + 1) * kstep;
            const char* a2 = last ? nA : cA + (size_t)(t + 2) * kstep; const char* b2 = last ? nB : cB + (size_t)(t + 2) * kstep;
            const char* a3 = a2 + kstep; const char* b3 = b2 + kstep;
            if (last && has_next) { S.a_ready(nxt); if constexpr (Epi::PREFETCH) E.pre(nxt, (ui + 1) & 1, wid, lane); }
            if constexpr (SP2) {
            PG8_LDB(B0, 0, 0); PG8_LDB(B1, 0, 1); PG8_SCHED; PG8_LDA(At, 0, 0); PG8_STAGE(PG8_SA(1, 1), a1 + hstep, voffA);
            PG8_WAIT_V(8); PG8_WAIT_L(0); PG8_BAR; PG8_MMA(0, 0, At, B0); PG8_MMA(0, 1, At, B1); PG8_BAR; PG8_SCHED;
            PG8_LDA(At, 0, 1); PG8_STAGE(PG8_SB(0, 0), b2, voffB); PG8_STAGE(PG8_SB(0, 1), b2 + hstep, voffB); PG8_STAGE(PG8_SA(0, 0), a2, voffA);
            PG8_WAIT_V(8); PG8_WAIT_L(0); PG8_BAR; PG8_MMA(1, 0, At, B0); PG8_MMA(1, 1, At, B1); PG8_BAR; PG8_SCHED;
            PG8_LDB(B0, 1, 0); PG8_LDB(B1, 1, 1); PG8_SCHED; PG8_LDA(At, 1, 0); PG8_STAGE(PG8_SA(0, 1), a2 + hstep, voffA);
            PG8_WAIT_V(8); PG8_WAIT_L(0); PG8_BAR; PG8_MMA(0, 0, At, B0); PG8_MMA(0, 1, At, B1); PG8_BAR; PG8_SCHED;
            PG8_LDA(At, 1, 1); PG8_STAGE(PG8_SB(1, 0), b3, voffB); PG8_STAGE(PG8_SB(1, 1), b3 + hstep, voffB); PG8_STAGE(PG8_SA(1, 0), a3, voffA);
            PG8_WAIT_V(8); PG8_WAIT_L(0); PG8_BAR; PG8_MMA(1, 0, At, B0); PG8_MMA(1, 1, At, B1); PG8_BAR; PG8_SCHED;
            } else {
            PG8_LDB(B0, 0, 0); PG8_SCHED; PG8_LDA(At, 0, 0); PG8_STAGE(PG8_SA(1, 1), a1 + hstep, voffA);
            PG8_WAIT_L(8); PG8_BAR; PG8_WAIT_L(0); PG8_MMA(0, 0, At, B0); PG8_BAR; PG8_SCHED;
            PG8_LDB(B1, 0, 1); PG8_STAGE(PG8_SB(0, 0), b2, voffB);
            PG8_BAR; PG8_WAIT_L(0); PG8_MMA(0, 1, At, B1); PG8_BAR;
            PG8_LDA(At, 0, 1); PG8_STAGE(PG8_SA(0, 0), a2, voffA);
            PG8_BAR; PG8_WAIT_L(0); PG8_MMA(1, 0, At, B0); PG8_BAR; PG8_SCHED;
            PG8_STAGE(PG8_SB(0, 1), b2 + hstep, voffB);
            PG8_WAIT_V(6); PG8_BAR; PG8_MMA(1, 1, At, B1); PG8_BAR;
            PG8_LDB(B0, 1, 0); PG8_SCHED; PG8_LDA(At, 1, 0); PG8_STAGE(PG8_SA(0, 1), a2 + hstep, voffA);
            PG8_WAIT_L(8); PG8_BAR; PG8_WAIT_L(0); PG8_MMA(0, 0, At, B0); PG8_BAR; PG8_SCHED;
            PG8_LDB(B1, 1, 1); PG8_STAGE(PG8_SB(1, 0), b3, voffB);
            PG8_BAR; PG8_WAIT_L(0); PG8_MMA(0, 1, At, B1); PG8_BAR;
            PG8_LDA(At, 1, 1); PG8_STAGE(PG8_SA(1, 0), a3, voffA);
            PG8_BAR; PG8_WAIT_L(0); PG8_MMA(1, 0, At, B0); PG8_BAR; PG8_SCHED;
            PG8_STAGE(PG8_SB(1, 1), b3 + hstep, voffB);
            PG8_WAIT_V(6); PG8_BAR; PG8_MMA(1, 1, At, B1); PG8_BAR;
            }
        }
        if constexpr (ALIGN_EPI) { if (wr == 0) PG8_BAR; }
        if constexpr (Epi::PREFETCH) { E.ep(acc, cur, wr, wc, fr, fq, ui & 1); S.done(cur); }
        else if constexpr (!Epi::AFTER_DRAIN) { E(acc, cur, wr, wc, fr, fq); S.done(cur); }
        if (!has_next) break;
#pragma unroll
        for (int a = 0; a < 2; ++a)
#pragma unroll
            for (int b = 0; b < 2; ++b)
#pragma unroll
                for (int m = 0; m < 4; ++m)
#pragma unroll
                    for (int n = 0; n < 2; ++n) acc[a][b][m][n] = (f32x4){0.f, 0.f, 0.f, 0.f};
        cur = nxt; cA = nA; cB = nB; ++ui;
        if constexpr (ALIGN_EPI) { if (wr == 1) PG8_BAR; }
    }
    PG8_WAIT_V(0);
    if constexpr (!ALIGN_EPI) { if (wr == 0) PG8_BAR; }
    PG8_BAR;
    if constexpr (Epi::AFTER_DRAIN) { E.fused(acc, cur, wr, wc, fr, fq, lds, wid, lane); S.done(cur); }
#undef PG8_SA
#undef PG8_SB
#undef PG8_STAGE
#undef PG8_STAGE_
#undef PG8_LDA
#undef PG8_LDB
#undef PG8_MMA
#undef PG8_WAIT_V
#undef PG8_WAIT_L
#undef PG8_BAR
#undef PG8_SCHED
}
}
namespace att {
using bf16 = __hip_bfloat16;
using bf16x8 = __attribute__((ext_vector_type(8))) short;
using s16x4 = __attribute__((ext_vector_type(4))) short;
using f32x16 = __attribute__((ext_vector_type(16))) float;
using u32x4 = __attribute__((ext_vector_type(4))) unsigned;
constexpr int SEQ = 4096, SLOTB = 8192;
constexpr int L_CK = 0, L_CV = 4 * SLOTB, L_K = 8 * SLOTB, L_V = 11 * SLOTB, L_WS = 14 * SLOTB, L_RK = L_WS + 8 * 256, L_OST = 0, L_YL = 0, ATT_LDS = L_RK + 8 * 2048;
typedef float f32x4_t __attribute__((ext_vector_type(4)));
constexpr float NEGBIG = -1e30f, FORCEV = 1e9f;
#define SBAR() __builtin_amdgcn_sched_barrier(0)
#define WAIT_BAR(N) asm volatile("s_waitcnt vmcnt(" #N ") lgkmcnt(0)\n\ts_barrier" ::: "memory")
__device__ __forceinline__ int crow(int r, int hi) { return (r & 3) + 8 * (r >> 2) + 4 * hi; }
__device__ __forceinline__ void glds16(const void* gsrc, unsigned lds_dst) { unsigned keep;
    asm volatile("s_mov_b32 %0, m0\n\ts_mov_b32 m0, %2\n\ts_nop 0\n\tglobal_load_lds_dwordx4 %1, off\n\ts_mov_b32 m0, %0" : "=&s"(keep) : "v"(gsrc), "s"(lds_dst) : "memory"); }
typedef float f32x2_t __attribute__((ext_vector_type(2))); typedef __bf16 bf16x2_t __attribute__((ext_vector_type(2)));
__device__ __forceinline__ unsigned cvtpk_s(float lo, float hi) { f32x2_t v = {lo, hi}; bf16x2_t b = __builtin_convertvector(v, bf16x2_t); return __builtin_bit_cast(unsigned, b); }
__device__ __forceinline__ float swap32f_(float v, int hi) { auto rr = __builtin_amdgcn_permlane32_swap(__float_as_uint(v), __float_as_uint(v), false, false); return __uint_as_float(hi ? rr[0] : rr[1]); }
#define swap32f(v) swap32f_((v), hi)
__device__ __forceinline__ void qkt(f32x16& p0, f32x16& p1, const char* Kslot, const bf16x8* qr, const f32x16& c0, int r32, int hi) {
    const char* kb = Kslot + hi * 1024 + r32 * 16;
    bf16x8 kf[8];
#pragma unroll
    for (int d0 = 0; d0 < 4; ++d0) { kf[2 * d0] = *reinterpret_cast<const bf16x8*>(kb + d0 * 2048); kf[2 * d0 + 1] = *reinterpret_cast<const bf16x8*>(kb + d0 * 2048 + 512); }
    SBAR();
    p0 = __builtin_amdgcn_mfma_f32_32x32x16_bf16(kf[0], qr[0], c0, 0, 0, 0); p1 = __builtin_amdgcn_mfma_f32_32x32x16_bf16(kf[1], qr[0], c0, 0, 0, 0);
#pragma unroll
    for (int d0 = 1; d0 < 4; ++d0) { p0 = __builtin_amdgcn_mfma_f32_32x32x16_bf16(kf[2 * d0], qr[d0], p0, 0, 0, 0); p1 = __builtin_amdgcn_mfma_f32_32x32x16_bf16(kf[2 * d0 + 1], qr[d0], p1, 0, 0, 0); }
    SBAR();
}
__device__ __forceinline__ void pv(f32x16* o, int vb, bf16x8 pa0, bf16x8 pa1, bf16x8 pa2, bf16x8 pa3) {
    s16x4 lo[8], hi[8];
#pragma unroll
    for (int d0 = 0; d0 < 2; ++d0)
#pragma unroll
        for (int ks = 0; ks < 4; ++ks) {
            asm volatile("ds_read_b64_tr_b16 %0,%1 offset:%c2" : "=&v"(lo[d0 * 4 + ks]) : "v"(vb), "i"(d0 * 4096 + ks * 1024) : "memory");
            asm volatile("ds_read_b64_tr_b16 %0,%1 offset:%c2" : "=&v"(hi[d0 * 4 + ks]) : "v"(vb), "i"(d0 * 4096 + ks * 1024 + 512) : "memory"); }
    asm volatile("s_waitcnt lgkmcnt(0)" ::: "memory"); SBAR();
#define PK(k) (bf16x8){lo[k][0], lo[k][1], lo[k][2], lo[k][3], hi[k][0], hi[k][1], hi[k][2], hi[k][3]}
#pragma unroll
    for (int d0 = 0; d0 < 2; ++d0) {
        o[d0] = __builtin_amdgcn_mfma_f32_32x32x16_bf16(pa0, PK(d0 * 4 + 0), o[d0], 0, 0, 0);
        o[d0] = __builtin_amdgcn_mfma_f32_32x32x16_bf16(pa1, PK(d0 * 4 + 1), o[d0], 0, 0, 0);
        o[d0] = __builtin_amdgcn_mfma_f32_32x32x16_bf16(pa2, PK(d0 * 4 + 2), o[d0], 0, 0, 0);
        o[d0] = __builtin_amdgcn_mfma_f32_32x32x16_bf16(pa3, PK(d0 * 4 + 3), o[d0], 0, 0, 0); }
#undef PK
}
__device__ __forceinline__ bf16x8 packp(const f32x16& p, int b, float sc) {
    u32x4 w; w.x = cvtpk_s(p[b] * sc, p[b + 1] * sc); w.y = cvtpk_s(p[b + 2] * sc, p[b + 3] * sc); w.z = cvtpk_s(p[b + 4] * sc, p[b + 5] * sc); w.w = cvtpk_s(p[b + 6] * sc, p[b + 7] * sc);
    return __builtin_bit_cast(bf16x8, w); }
__device__ __forceinline__ float dpp_xor1(float v) { return __int_as_float(__builtin_amdgcn_update_dpp(0, __float_as_int(v), 0xB1, 0xF, 0xF, false)); }
__device__ __forceinline__ float dpp_xor2(float v) { return __int_as_float(__builtin_amdgcn_update_dpp(0, __float_as_int(v), 0x4E, 0xF, 0xF, false)); }
__device__ __forceinline__ float sel4(int h4, float a, float b, float c, float d) { return h4 == 0 ? a : (h4 == 1 ? b : (h4 == 2 ? c : d)); }

#define FLASH flash_branch4
struct AttnPtrs { const bf16* Q; const bf16* CMPK; const bf16* CMPV; const bf16* KS; const bf16* VS; const bf16* KW; const bf16* VW; const float* GNSA; bf16* YB; };
struct AttnP { unsigned char* ws; const float* caw; const float* kng; };

#define ATT_DMA_K(base, tile, ldsoff) glds16((base) + (long)(tile) * 4096 + koff, (unsigned)__builtin_amdgcn_readfirstlane(lds0 + (unsigned)(ldsoff) + (unsigned)wid * 1024u))
#define ATT_DMA_V(base, tile, ldsoff) glds16((base) + (long)(tile) * 4096 + voff, (unsigned)__builtin_amdgcn_readfirstlane(lds0 + (unsigned)(ldsoff) + (unsigned)wid * 1024u))

typedef __attribute__((address_space(3))) const char* lds_cptr;
typedef short v4i16_t __attribute__((ext_vector_type(4)));
__device__ __forceinline__ s16x4 vtr(lds_cptr p) { return __builtin_bit_cast(s16x4, __builtin_amdgcn_ds_read_tr16_b64_v4i16((__attribute__((address_space(3))) v4i16_t*)p)); }
#define WAITV_BAR(N) asm volatile("s_waitcnt vmcnt(" #N ") lgkmcnt(0)\n\ts_barrier" ::: "memory")
#define F4_PIN(x) asm volatile("" : "+v"(x))
template <int MODE> __device__ __forceinline__ void flash_branch4(const bf16* Kb, const bf16* Vb, int b, int g, int c, unsigned sel_lo, unsigned sel_hi, const float* GNSA, const bf16* Q, const float* kgain, char* shm) {
    int tid = threadIdx.x; asm volatile("" : "+v"(tid));
    const int lane = tid & 63, r32 = lane & 31, hi = lane >> 5; const int wid = __builtin_amdgcn_readfirstlane(tid >> 6);
    const int qi = 8 * wid + (r32 >> 2), head = 4 * g + (r32 & 3); const long row = (long)b * SEQ + 64 * c + qi;
    const unsigned lds0 = (unsigned)(uintptr_t)shm; float* wsf = (float*)(shm + L_WS) + wid * 64; float* yl = (float*)(shm + L_YL) + wid * 2048 + lane;
    const int koff = lane * 64 + wid * 8, voff = (16 * (wid & 3) + (lane >> 2)) * 64 + (wid >> 2) * 32 + (lane & 3) * 8;
    const int vbl = ((lane >> 4) & 1) * 32 + (lane & 3) * 8 + (4 * hi + ((lane & 15) >> 2)) * 64;
    const float* gatep = GNSA + row * 24 + head * 3 + (MODE == 0 ? 1 : 2); const bf16* qp = Q + row * 512 + head * 64 + hi * 8;
    const int j0 = (MODE == 0) ? 0 : (c > 8 ? c - 8 : 0); const int NT = c - j0 + 1;
    float zz = 0.f; asm volatile("" : "+v"(zz));
    float mhat = 0.f; f32x16 o[2], negm, lac;
#pragma unroll
    for (int r = 0; r < 16; ++r) { o[0][r] = zz; o[1][r] = zz; negm[r] = zz; lac[r] = zz; }
    const bf16x8 ones = {16256, 16256, 16256, 16256, 16256, 16256, 16256, 16256};
    const lds_cptr kp0 = (lds_cptr)shm + L_K + hi * 1024 + r32 * 16;
    const lds_cptr vp0 = (lds_cptr)shm + L_V + vbl;
    bf16x8 kf[8]; f32x16 pA0, pA1, pB0, pB1; bool resc = false;
    s16x4 vlo[8], vhi[8]; u32x4 pw0, pw1, pw2, pw3;
    int sl_prev = 0, sl_cur = 0, sl_next = SLOTB;
#define F4_ROT() do { sl_prev = sl_cur; sl_cur = sl_next; sl_next = (sl_next == 2 * SLOTB) ? 0 : sl_next + SLOTB; } while (0)
#define F4_ALLOWED(t_) ((MODE != 0) ? true : (((j0 + (t_)) < 32) ? (((sel_lo >> (j0 + (t_))) & 1u) != 0u) : (((sel_hi >> (j0 + (t_) - 32)) & 1u) != 0u)))
#define F4_MASK(P0_, P1_, t_) do { const int j_ = j0 + (t_); \
        if (j_ == c) { _Pragma("unroll") for (int r = 0; r < 16; ++r) { const int kk = crow(r, hi); P0_[r] = (kk <= qi) ? P0_[r] : NEGBIG; P1_[r] = (kk + 32 <= qi) ? P1_[r] : NEGBIG; } } \
        else if (MODE == 1 && j_ == c - 8) { _Pragma("unroll") for (int r = 0; r < 16; ++r) { const int kk = crow(r, hi); P0_[r] = (kk > qi) ? P0_[r] : NEGBIG; P1_[r] = (kk + 32 > qi) ? P1_[r] : NEGBIG; } } } while (0)
#define F4_RMAX(C0_, C1_, rm_) do { float a_ = fmaxf(fmaxf(C0_[0], C0_[1]), C1_[0]), b_ = fmaxf(fmaxf(C0_[2], C0_[3]), C1_[1]); a_ = fmaxf(fmaxf(a_, C1_[2]), C1_[3]); \
        _Pragma("unroll") for (int r = 4; r < 16; r += 4) { a_ = fmaxf(fmaxf(a_, C0_[r]), C0_[r + 1]); b_ = fmaxf(fmaxf(b_, C0_[r + 2]), C0_[r + 3]); a_ = fmaxf(fmaxf(a_, C1_[r]), C1_[r + 1]); b_ = fmaxf(fmaxf(b_, C1_[r + 2]), C1_[r + 3]); } \
        rm_ = fmaxf(a_, b_); rm_ = fmaxf(rm_, swap32f(rm_)); } while (0)
#define F4_DECIDE(C0_, C1_, al_) do { if (track) { float rm_; F4_RMAX(C0_, C1_, rm_); rm_ = (al_) ? rm_ : NEGBIG; resc = false; \
        if (__builtin_expect(__any(rm_ > 8.0f), 0)) { const float dl = fmaxf(rm_, 0.f); mhat += dl; \
            _Pragma("unroll") for (int r = 0; r < 16; ++r) { C0_[r] -= dl; C1_[r] -= dl; } \
            _Pragma("unroll") for (int r = 0; r < 16; ++r) negm[r] = -mhat; F4_PIN(negm); \
            const float f_ = __builtin_amdgcn_exp2f(-dl); if (hi == 0) wsf[r32] = f_; resc = true; } } } while (0)
#define F4_RESC() do { if (resc) { asm volatile("s_waitcnt lgkmcnt(0)" ::: "memory"); \
        _Pragma("unroll") for (int r = 0; r < 16; ++r) { const float fr_ = wsf[crow(r, hi)]; o[0][r] *= fr_; o[1][r] *= fr_; lac[r] *= fr_; } } } while (0)
#define F4_PKW(P, B) (cvtpk_s(P[B], P[B + 1]) & pmask)
#define F4_PAF(k) __builtin_bit_cast(bf16x8, pw##k)
#define F4_VFR(i) (bf16x8){vlo[i][0], vlo[i][1], vlo[i][2], vlo[i][3], vhi[i][0], vhi[i][1], vhi[i][2], vhi[i][3]}
#define F4_MF(a, b, cc) __builtin_amdgcn_mfma_f32_32x32x16_bf16(a, b, cc, 0, 0, 0)
#define F4_GAPA(MFs, A0, A1, A2, A3, W0, W1, PW) do { MFs; W0; W1; F4_PIN(PW); SBAR(); } while (0)
#define F4_EX(v) __builtin_amdgcn_exp2f(v)
#define F4_GAPB(MFs, X, B) do { MFs; X[B] = F4_EX(X[B]); X[B + 1] = F4_EX(X[B + 1]); X[B + 2] = F4_EX(X[B + 2]); X[B + 3] = F4_EX(X[B + 3]); F4_PIN(X); SBAR(); } while (0)
#define F4_VRD(i) do { vlo[i] = vtr(vp_ + (((i) >> 2) * 4096 + ((i) & 3) * 1024)); vhi[i] = vtr(vp_ + (((i) >> 2) * 4096 + ((i) & 3) * 1024 + 512)); } while (0)
#define F4_KRD(G, jj) do { if (G) { const lds_cptr kp_ = kp0 + sl_next; kf[2 * (jj)] = *(const __attribute__((address_space(3))) bf16x8*)(kp_ + (jj) * 2048); kf[2 * (jj) + 1] = *(const __attribute__((address_space(3))) bf16x8*)(kp_ + (jj) * 2048 + 512); SBAR(); } } while (0)
#define F4_STEP(C0, C1, P0, P1, t_, FULL) do { SBAR(); const int tt_ = (t_); const bool GK = (FULL) || tt_ + 3 < NT, GV = (FULL) || tt_ + 1 < NT, GL = GV;     \
        const lds_cptr vp_ = vp0 + sl_prev; const bool al_cur = F4_ALLOWED(tt_); \
        F4_VRD(0); SBAR(); \
        F4_GAPA(C0 = F4_MF(kf[0], qr[0], negm), P0[2], P0[3], P0[4], P0[5], pw0[0] = F4_PKW(P0, 0), pw0[1] = F4_PKW(P0, 2), pw0); \
        F4_VRD(4); SBAR(); F4_GAPA(C1 = F4_MF(kf[1], qr[0], negm), P0[6], P0[7], P0[8], P0[9], pw0[2] = F4_PKW(P0, 4), pw0[3] = F4_PKW(P0, 6), pw0); \
        F4_VRD(1); SBAR(); F4_GAPA(C0 = F4_MF(kf[2], qr[1], C0), P0[10], P0[11], P0[12], P0[13], pw1[0] = F4_PKW(P0, 8), pw1[1] = F4_PKW(P0, 10), pw1); \
        F4_VRD(5); SBAR(); F4_GAPA(C1 = F4_MF(kf[3], qr[1], C1), P0[14], P0[15], P1[0], P1[1], pw1[2] = F4_PKW(P0, 12), pw1[3] = F4_PKW(P0, 14), pw1); \
        F4_GAPA(C0 = F4_MF(kf[4], qr[2], C0), P1[2], P1[3], P1[4], P1[5], pw2[0] = F4_PKW(P1, 0), pw2[1] = F4_PKW(P1, 2), pw2); \
        F4_GAPA(C1 = F4_MF(kf[5], qr[2], C1), P1[6], P1[7], P1[8], P1[9], pw2[2] = F4_PKW(P1, 4), pw2[3] = F4_PKW(P1, 6), pw2); \
        F4_GAPA(C0 = F4_MF(kf[6], qr[3], C0), P1[10], P1[11], P1[12], P1[13], pw3[0] = F4_PKW(P1, 8), pw3[1] = F4_PKW(P1, 10), pw3); \
        F4_GAPA(C1 = F4_MF(kf[7], qr[3], C1), P1[14], P1[15], 0.f, 0.f, pw3[2] = F4_PKW(P1, 12), pw3[3] = F4_PKW(P1, 14), pw3); \
        pmask = al_cur ? 0xffffffffu : 0u; \
        if (GK) { ATT_DMA_K(Kb, j0 + tt_ + 3, L_K + sl_cur); } if (GV) { ATT_DMA_V(Vb, j0 + tt_ + 1, L_V + sl_next); } \
        if (!(FULL)) { F4_MASK(C0, C1, tt_); } \
        F4_DECIDE(C0, C1, al_cur); \
        SBAR(); \
        F4_VRD(2); SBAR(); F4_GAPB(o[0] = F4_MF(F4_PAF(0), F4_VFR(0), o[0]), C0, 0); \
        F4_VRD(6); SBAR(); F4_GAPB(o[1] = F4_MF(F4_PAF(0), F4_VFR(4), o[1]); lac = F4_MF(F4_PAF(0), ones, lac), C0, 4); \
        F4_VRD(3); SBAR(); F4_KRD(GL, 0); F4_GAPB(o[0] = F4_MF(F4_PAF(1), F4_VFR(1), o[0]), C0, 8); \
        F4_VRD(7); SBAR(); F4_KRD(GL, 1); F4_GAPB(o[1] = F4_MF(F4_PAF(1), F4_VFR(5), o[1]); lac = F4_MF(F4_PAF(1), ones, lac), C0, 12); \
        F4_KRD(GL, 2); F4_GAPB(o[0] = F4_MF(F4_PAF(2), F4_VFR(2), o[0]), C1, 0); \
        F4_KRD(GL, 3); F4_GAPB(o[1] = F4_MF(F4_PAF(2), F4_VFR(6), o[1]); lac = F4_MF(F4_PAF(2), ones, lac), C1, 4); \
        F4_GAPB(o[0] = F4_MF(F4_PAF(3), F4_VFR(3), o[0]), C1, 8); \
        F4_GAPB(o[1] = F4_MF(F4_PAF(3), F4_VFR(7), o[1]); lac = F4_MF(F4_PAF(3), ones, lac), C1, 12);     \
        SBAR(); \
          \
        if (GK) { WAITV_BAR(2); } else if (GV) { WAITV_BAR(1); } else { WAITV_BAR(0); } \
        F4_RESC(); F4_ROT(); } while (0)
    {
    ATT_DMA_K(Kb, j0, L_K); ATT_DMA_V(Vb, j0, L_V);
    if (NT > 1) { ATT_DMA_K(Kb, j0 + 1, L_K + SLOTB); }
    if (NT > 2) { ATT_DMA_K(Kb, j0 + 2, L_K + 2 * SLOTB); } }
    bf16x8 qr[4];
#pragma unroll
    for (int d0 = 0; d0 < 4; ++d0) qr[d0] = *reinterpret_cast<const bf16x8*>(qp + d0 * 16);
    WAITV_BAR(0);
    bool track;
    { float qq = 0.f;
#pragma unroll
      for (int d0 = 0; d0 < 4; ++d0)
#pragma unroll
        for (int e = 0; e < 8; ++e) { const float v = __uint_as_float(((unsigned)(unsigned short)qr[d0][e]) << 16); qq += v * v; }
      qq += swap32f(qq);
      float gm = fabsf(kgain[lane]);
      gm = fmaxf(gm, dpp_xor1(gm)); gm = fmaxf(gm, dpp_xor2(gm));
#pragma unroll
      for (int o = 4; o < 64; o <<= 1) gm = fmaxf(gm, __shfl_xor(gm, o));
      track = !__all(sqrtf(qq) * 8.0f * gm < 40.0f); }
    qkt(pA0, pA1, shm + L_K, qr, negm, r32, hi);
    F4_MASK(pA0, pA1, 0);
    unsigned pmask = F4_ALLOWED(0) ? 0xffffffffu : 0u;
    F4_DECIDE(pA0, pA1, pmask != 0u);
#pragma unroll
    for (int r = 0; r < 16; ++r) { pA0[r] = F4_EX(pA0[r]); pA1[r] = F4_EX(pA1[r]); }
    WAITV_BAR(0);
    if (NT > 3) { ATT_DMA_K(Kb, j0 + 3, L_K); }
    if (NT > 1) { ATT_DMA_V(Vb, j0 + 1, L_V + SLOTB); }
    F4_ROT();
    if (NT > 1) { const lds_cptr kp_ = kp0 + sl_cur;
        kf[0] = *(const __attribute__((address_space(3))) bf16x8*)(kp_); kf[1] = *(const __attribute__((address_space(3))) bf16x8*)(kp_ + 512);
        kf[2] = *(const __attribute__((address_space(3))) bf16x8*)(kp_ + 2048); kf[3] = *(const __attribute__((address_space(3))) bf16x8*)(kp_ + 2560);
        kf[4] = *(const __attribute__((address_space(3))) bf16x8*)(kp_ + 4096); kf[5] = *(const __attribute__((address_space(3))) bf16x8*)(kp_ + 4608);
        kf[6] = *(const __attribute__((address_space(3))) bf16x8*)(kp_ + 6144); kf[7] = *(const __attribute__((address_space(3))) bf16x8*)(kp_ + 6656); }
    if (NT > 3) { WAITV_BAR(2); } else if (NT > 1) { WAITV_BAR(1); } else { WAITV_BAR(0); }
    int t = 1; bool lastB = false;
    for (; t + 4 < NT; t += 2) {
        F4_STEP(pB0, pB1, pA0, pA1, t, true);
        F4_STEP(pA0, pA1, pB0, pB1, t + 1, true);
    }
    while (t < NT) {
        F4_STEP(pB0, pB1, pA0, pA1, t, false); ++t; lastB = true;
        if (t >= NT) break;
        F4_STEP(pA0, pA1, pB0, pB1, t, false); ++t; lastB = false;
    }
    if (lastB) { pA0 = pB0; pA1 = pB1; }
    {
      pw0 = (u32x4){F4_PKW(pA0, 0), F4_PKW(pA0, 2), F4_PKW(pA0, 4), F4_PKW(pA0, 6)}; pw1 = (u32x4){F4_PKW(pA0, 8), F4_PKW(pA0, 10), F4_PKW(pA0, 12), F4_PKW(pA0, 14)};
      pw2 = (u32x4){F4_PKW(pA1, 0), F4_PKW(pA1, 2), F4_PKW(pA1, 4), F4_PKW(pA1, 6)}; pw3 = (u32x4){F4_PKW(pA1, 8), F4_PKW(pA1, 10), F4_PKW(pA1, 12), F4_PKW(pA1, 14)};
      SBAR(); pv(o, (int)(lds0 + L_V + sl_prev) + vbl, F4_PAF(0), F4_PAF(1), F4_PAF(2), F4_PAF(3));
      lac = F4_MF(F4_PAF(0), ones, lac); lac = F4_MF(F4_PAF(1), ones, lac); lac = F4_MF(F4_PAF(2), ones, lac); lac = F4_MF(F4_PAF(3), ones, lac); }
    if (hi == 0) wsf[r32] = *gatep;
    asm volatile("s_waitcnt lgkmcnt(0)" ::: "memory");
#pragma unroll
    for (int r = 0; r < 16; ++r) { const float fr_ = wsf[crow(r, hi)] * __builtin_amdgcn_rcpf(lac[r]); yl[r * 64] += o[0][r] * fr_; yl[(16 + r) * 64] += o[1][r] * fr_; }
    WAIT_BAR(0);
#undef F4_ROT
#undef F4_ALLOWED
#undef F4_MASK
#undef F4_RMAX
#undef F4_DECIDE
#undef F4_RESC
#undef F4_CV
#undef F4_PKW
#undef F4_PAF
#undef F4_VFR
#undef F4_MF
#undef F4_GAPA
#undef F4_EX
#undef F4_GAPB
#undef F4_VRD
#undef F4_KRD
#undef F4_STEP
}
#undef F4_PIN


template <int DRY> __device__ __forceinline__ void attn_unit(int b, int g, int c, const AttnP& PP, char* shm) {
    int tid = threadIdx.x; asm volatile("" : "+v"(tid));
    unsigned char* wsb = PP.ws; asm volatile("" : "+s"(wsb));
    const AttnPtrs P{(const bf16*)(wsb + WS_Q), (const bf16*)(wsb + WS_CMPK), (const bf16*)(wsb + WS_CMPV), (const bf16*)(wsb + WS_KS), (const bf16*)(wsb + WS_VS), (const bf16*)(wsb + WS_KW), (const bf16*)(wsb + WS_VW), (const float*)(wsb + WS_GNSA), (bf16*)(wsb + WS_YAB)};
    const int lane = tid & 63, r32 = lane & 31, hi = lane >> 5; const int wid = __builtin_amdgcn_readfirstlane(tid >> 6);
    const int qi = 8 * wid + (r32 >> 2), h4 = r32 & 3, head = 4 * g + h4;
    const int t = 64 * c + qi; const long row = (long)b * SEQ + t;
    const unsigned lds0 = (unsigned)(uintptr_t)shm;
    float* wsf = (float*)(shm + L_WS) + wid * 64;
    const long bg = (long)(b * 2 + g);
    const bf16* CKb = P.CMPK + bg * 256 * 64; const bf16* CVb = P.CMPV + bg * 256 * 64;
    const int koff = lane * 64 + wid * 8;
    const int voff = (16 * (wid & 3) + (lane >> 2)) * 64 + (wid >> 2) * 32 + (lane & 3) * 8;
    const int vbl = ((lane >> 4) & 1) * 32 + (lane & 3) * 8 + (4 * hi + ((lane & 15) >> 2)) * 64;
    const int nsl = (((4 * c + 2) >> 6) + 1 < 4) ? ((4 * c + 2) >> 6) + 1 : 4;
    for (int j = 0; j < nsl; ++j) { ATT_DMA_K(CKb, j, L_CK + j * SLOTB); ATT_DMA_V(CVb, j, L_CV + j * SLOTB); }
    const int chn = 256 * g + (tid & 31) * 8, rg = tid >> 5; const long t0 = (long)b * SEQ + 64 * c + 4 * rg;
    f32x4_t cw0[2], cw1[2], cw2[2]; u32x4 cp2 = {0u, 0u, 0u, 0u}, cp1 = cp2, ccu[4], cav[4];
    if (DRY == 0) {
        const bf16* ACX = (const bf16*)(wsb + WS_ACX); const bf16* AB = (const bf16*)(wsb + WS_AB);
#pragma unroll
        for (int j = 0; j < 2; ++j) { cw0[j] = *(const f32x4_t*)(PP.caw + chn + 4 * j); cw1[j] = *(const f32x4_t*)(PP.caw + 512 + chn + 4 * j); cw2[j] = *(const f32x4_t*)(PP.caw + 1024 + chn + 4 * j); }
        if (c != 0 || rg != 0) { cp2 = *(const u32x4*)(ACX + (t0 - 2) * 512 + chn); cp1 = *(const u32x4*)(ACX + (t0 - 1) * 512 + chn); }
#pragma unroll
        for (int rr = 0; rr < 4; ++rr) { ccu[rr] = *(const u32x4*)(ACX + (t0 + rr) * 512 + chn); cav[rr] = *(const u32x4*)(AB + (t0 + rr) * 512 + chn); }
    }
    bf16x8 qr[4];
#pragma unroll
    for (int d0 = 0; d0 < 4; ++d0) qr[d0] = *reinterpret_cast<const bf16x8*>(P.Q + row * 512 + head * 64 + d0 * 16 + hi * 8);
    const float g0 = P.GNSA[row * 24 + head * 3 + 0];
    f32x16 y[2]; y[0] = f32x16{}; y[1] = f32x16{};
    WAIT_BAR(0);
    if (DRY == 0) { bf16* YA = (bf16*)(wsb + WS_YAB) + 512;
#pragma unroll
        for (int rr = 0; rr < 4; ++rr) { const u32x4 cu = ccu[rr], av = cav[rr]; u32x4 ov;
#pragma unroll
            for (int q = 0; q < 4; ++q) { const int j2 = q >> 1, e = (2 * q) & 3;
                const float lo = cw0[j2][e] * __uint_as_float(cp2[q] << 16) + cw1[j2][e] * __uint_as_float(cp1[q] << 16) + cw2[j2][e] * __uint_as_float(cu[q] << 16);
                const float hi_ = cw0[j2][e + 1] * __uint_as_float(cp2[q] & 0xffff0000u) + cw1[j2][e + 1] * __uint_as_float(cp1[q] & 0xffff0000u) + cw2[j2][e + 1] * __uint_as_float(cu[q] & 0xffff0000u);
                ov[q] = cvtpk_s(lo * __uint_as_float(av[q] << 16), hi_ * __uint_as_float(av[q] & 0xffff0000u)); }
            *(u32x4*)(YA + (t0 + rr) * 1024 + chn) = ov; cp2 = cp1; cp1 = cu; }
        SBAR(); }
    unsigned sel_lo, sel_hi;
    {
        const f32x16 z = f32x16{};
        const int kmax = (t >= 31) ? ((t - 31) >> 4) : -1;
        float mref = 0.f, ls = 0.f, ogp = 0.f; float imp[32];
#pragma unroll
        for (int i = 0; i < 32; ++i) imp[i] = 0.f;
#pragma unroll
        for (int sl = 0; sl < 4; ++sl) if (sl < nsl) {
            f32x16 p0, p1; qkt(p0, p1, shm + L_CK + sl * SLOTB, qr, z, r32, hi);
            float tm = NEGBIG;
#pragma unroll
            for (int r = 0; r < 16; ++r) { const int k = 64 * sl + crow(r, hi); p0[r] = (k <= kmax) ? p0[r] : NEGBIG; p1[r] = (k + 32 <= kmax) ? p1[r] : NEGBIG; tm = fmaxf(tm, fmaxf(p0[r], p1[r])); }
            tm = fmaxf(tm, swap32f(tm));
            if (sl == 0) { mref = (tm > -1e29f) ? tm : 0.f; }
            else if (__any(tm - mref > 8.0f)) {
                const float dl = fmaxf(tm - mref, 0.f); mref += dl; const float f = __builtin_amdgcn_exp2f(-dl); ls *= f; ogp *= f;
#pragma unroll
                for (int i = 0; i < 32; ++i) imp[i] *= f;
                if (hi == 0) wsf[r32] = f;
                asm volatile("s_waitcnt lgkmcnt(0)" ::: "memory");
#pragma unroll
                for (int r = 0; r < 16; ++r) { const float fr_ = wsf[crow(r, hi)]; y[0][r] *= fr_; y[1][r] *= fr_; }
            }
#pragma unroll
            for (int r = 0; r < 16; ++r) { p0[r] = __builtin_amdgcn_exp2f(p0[r] - mref); p1[r] = __builtin_amdgcn_exp2f(p1[r] - mref); ls += p0[r] + p1[r]; }
#pragma unroll
            for (int w = 0; w < 2; ++w)
#pragma unroll
                for (int rg = 0; rg < 4; ++rg) { const int i = 8 * sl + 4 * w + rg; const f32x16& e = w ? p1 : p0;
                    const float gs = (e[4 * rg] + e[4 * rg + 1]) + (e[4 * rg + 2] + e[4 * rg + 3]); const float gl = e[4 * rg + 3];
                    const float og = swap32f(gl);
                    imp[i] = gs + (hi ? og : ogp); ogp = og; }
            const bf16x8 pa0 = packp(p0, 0, 1.f), pa1 = packp(p0, 8, 1.f), pa2 = packp(p1, 0, 1.f), pa3 = packp(p1, 8, 1.f);
            SBAR();
            pv(y, (int)(lds0 + L_CV + sl * SLOTB) + vbl, pa0, pa1, pa2, pa3);
            SBAR();
        }
        ls += swap32f(ls);
        const float inv = ls > 0.f ? 1.0f / ls : 0.f;
        if (hi == 0) wsf[r32] = g0 * inv;
        asm volatile("s_waitcnt lgkmcnt(0)" ::: "memory");
#pragma unroll
        for (int r = 0; r < 16; ++r) { const float fr_ = wsf[crow(r, hi)]; y[0][r] *= fr_; y[1][r] *= fr_; }
        unsigned mlo = 0xffffffffu, mhi = 0xffffffffu;
        if (c >= 16) { mlo = 0u; mhi = 0u;
        unsigned* rk = (unsigned*)(shm + L_RK) + wid * 512 + (r32 >> 2) * 64;
        const int jb = 16 * h4 + hi;
#pragma unroll
        for (int i = 0; i < 32; ++i) { float v = imp[i] * inv; v += dpp_xor1(v); v += dpp_xor2(v);
            const int jc = 2 * i + hi;
            unsigned key = (__float_as_uint(v) & 0xFFFFFFC0u) | (unsigned)(63 - jc);
            key = (jc == 0 || jc == c || jc == c - 1) ? (0xFFFFFFC0u | (unsigned)(63 - jc)) : (jc <= c ? key : (unsigned)(63 - jc));
            rk[jc] = key; }
        asm volatile("s_waitcnt lgkmcnt(0)" ::: "memory");
        int rank[8]; unsigned cand[8];
#pragma unroll
        for (int u = 0; u < 8; ++u) { rank[u] = 0; cand[u] = rk[jb + 2 * u]; }
        const int nch = (c >> 2) + 1;
#pragma unroll 4
        for (int ch = 0; ch < nch; ++ch) { const u32x4 v4 = *(const u32x4*)(rk + 4 * ch);
#pragma unroll
            for (int e = 0; e < 4; ++e) { const unsigned v = v4[e];
#pragma unroll
                for (int u = 0; u < 8; ++u) rank[u] += (v > cand[u]) ? 1 : 0; } }
#pragma unroll
        for (int u = 0; u < 8; ++u) { const int jc = jb + 2 * u; if (rank[u] < 16) { if (jc < 32) mlo |= 1u << jc; else mhi |= 1u << (jc - 32); } }
        mlo |= __float_as_uint(dpp_xor1(__uint_as_float(mlo))); mlo |= __float_as_uint(dpp_xor2(__uint_as_float(mlo))); mlo |= __float_as_uint(swap32f(__uint_as_float(mlo)));
        mhi |= __float_as_uint(dpp_xor1(__uint_as_float(mhi))); mhi |= __float_as_uint(dpp_xor2(__uint_as_float(mhi))); mhi |= __float_as_uint(swap32f(__uint_as_float(mhi)));
        }
        const unsigned vlo = (c >= 31) ? 0xffffffffu : ((2u << c) - 1u);
        const unsigned vhi = (c < 32) ? 0u : ((c >= 63) ? 0xffffffffu : ((2u << (c - 32)) - 1u));
        sel_lo = mlo & vlo; sel_hi = mhi & vhi;
#ifdef SELFCHECK
        if (h4 == 0 && hi == 0 && DRY == 0) { unsigned* mk = (unsigned*)(wsb + (58u << 20)) + ((size_t)row * 2 + g) * 2; mk[0] = sel_lo; mk[1] = sel_hi; }
#endif
    }
    SBAR();
    asm volatile("s_waitcnt vmcnt(0) lgkmcnt(0)\n\ts_barrier" ::: "memory");
    if (DRY == 1) { asm volatile("" :: "v"(sel_lo), "v"(sel_hi), "v"(y[0]), "v"(y[1])); asm volatile("s_waitcnt vmcnt(0) lgkmcnt(0)\n\ts_barrier" ::: "memory"); return; }
    float* yl = (float*)(shm + L_YL) + wid * 2048 + lane;
#pragma unroll
    for (int r = 0; r < 16; ++r) { yl[r * 64] = y[0][r]; yl[(16 + r) * 64] = y[1][r]; }
    const bf16* KSb = P.KS + bg * SEQ * 64; const bf16* VSb = P.VS + bg * SEQ * 64; const bf16* KWb = P.KW + bg * SEQ * 64; const bf16* VWb = P.VW + bg * SEQ * 64;
#ifndef NO_FLASH0
    if (DRY != 2)
    FLASH<0>(KSb, VSb, b, g, c, sel_lo, sel_hi, P.GNSA, P.Q, PP.kng + 64, shm);
#else
    y[0][0] += (float)(sel_lo ^ sel_hi);
#endif
#ifndef NO_FLASH1
    if (DRY != 3 && DRY < 4)
    FLASH<1>(KWb, VWb, b, g, c, 0u, 0u, P.GNSA, P.Q, PP.kng + 128, shm);
#endif
    {   int tid2 = threadIdx.x; asm volatile("" : "+v"(tid2)); const int lane = tid2 & 63, r32 = lane & 31, hi = lane >> 5; const int wid = __builtin_amdgcn_readfirstlane(tid2 >> 6); float* yl = (float*)(shm + L_YL) + wid * 2048 + lane;
#pragma unroll
        for (int r = 0; r < 16; ++r) { y[0][r] = yl[r * 64]; y[1][r] = yl[(16 + r) * 64]; }
        asm volatile("s_waitcnt lgkmcnt(0)" ::: "memory");
        bf16* stg = (bf16*)(shm + L_OST) + wid * 4096;
#pragma unroll
        for (int r = 0; r < 16; ++r) { const int orow = crow(r, hi);
#pragma unroll
            for (int d0 = 0; d0 < 2; ++d0) stg[orow * 64 + d0 * 32 + r32] = __float2bfloat16(y[d0][r]); }
        asm volatile("s_waitcnt lgkmcnt(0)" ::: "memory");
#pragma unroll
        for (int i = 0; i < 4; ++i) { const int rowl = i * 8 + (lane >> 3), ch = lane & 7; const u32x4 v = *(const u32x4*)(stg + rowl * 64 + ch * 8);
            bf16* dst = P.YB + ((long)b * SEQ + 64 * c + 8 * wid + (rowl >> 2)) * 1024 + (4 * g + (rowl & 3)) * 64 + ch * 8; *(u32x4*)dst = v; }
    }
    asm volatile("s_waitcnt lgkmcnt(0)\n\ts_barrier" ::: "memory");
}
#undef SBAR
#undef WAIT_BAR
#undef swap32f
}
constexpr int NWAVES = 8;
#ifndef MK_N_LAUNCHES
#define MK_N_LAUNCHES 1
#endif
constexpr int N_PHASES = 8;
constexpr int N_LAUNCHES = MK_N_LAUNCHES;
constexpr int RING_OFF = 0, RING_BYTES = 131072, ATT_BYTES = 133120, LDSCTL_OFF = ATT_BYTES, MISC_OFF = LDSCTL_OFF + 320, LDS_BYTES = 147456;
static_assert(att::ATT_LDS <= ATT_BYTES && RING_BYTES <= ATT_BYTES && LDSCTL_OFF + 1024 + 4096 + 2048 + 4096 <= LDS_BYTES, "LDS map");

#define GAS __attribute__((address_space(1)))
#define LAS __attribute__((address_space(3)))
typedef unsigned short bf16;
typedef unsigned v4u __attribute__((ext_vector_type(4)));
typedef float f32x4 __attribute__((ext_vector_type(4)));
typedef short bf16x8 __attribute__((ext_vector_type(8)));
typedef GAS unsigned gu32;
#define RLX_AGENT __ATOMIC_RELAXED, __HIP_MEMORY_SCOPE_AGENT
#define LDS_WAIT() asm volatile("s_waitcnt lgkmcnt(0)" ::: "memory")
#define VM_WAIT() asm volatile("s_waitcnt vmcnt(0)" ::: "memory")
__device__ __forceinline__ unsigned f2bf(float f) { unsigned u = __builtin_bit_cast(unsigned, f); return (u + 0x7fffu + ((u >> 16) & 1u)) >> 16; }
__device__ __forceinline__ unsigned pk2(float lo, float hi) { return f2bf(lo) | (f2bf(hi) << 16); }
__device__ __forceinline__ float bflo(unsigned w) { return __uint_as_float(w << 16); }
__device__ __forceinline__ float bfhi(unsigned w) { return __uint_as_float(w & 0xffff0000u); }
#define XB_TMO      128
#define XB_XCNT(j)  (256  + 64 * (j))
#define XB_XSUB(j)  (1280 + 64 * (j))
#define XB_XGEN(j)  (2304 + 64 * (j))
#define XB_TOP      3328
#define XB_TOPGEN   3392
#define XCD_BAR_WORDS 3456
#ifdef SELFCHECK
#define XB_SPIN_CAP (1u << 25)
#else
#define XB_SPIN_CAP (1u << 18)
#endif

__device__ __forceinline__ unsigned xb_ld(unsigned* p)              { return __hip_atomic_load(p, __ATOMIC_RELAXED, __HIP_MEMORY_SCOPE_AGENT); }
__device__ __forceinline__ unsigned xb_add(unsigned* p, unsigned v) { return __hip_atomic_fetch_add(p, v, __ATOMIC_RELAXED, __HIP_MEMORY_SCOPE_AGENT); }
__device__ __forceinline__ unsigned xb_xcc_id() { return (unsigned)__builtin_amdgcn_s_getreg((3 << 11) | 20) & 0xFu; }
#define XB_SPIN(cond, bar) do { unsigned _sp = 0; while (cond) { __builtin_amdgcn_s_sleep(1); \
    if ((++_sp & 255u) == 0u) { if (xb_ld(&(bar)[XB_TMO])) break; if (_sp > XB_SPIN_CAP) { atomicAdd(&(bar)[XB_TMO], 1u); break; } } } } while (0)

struct XcdBarrier {
    unsigned* bar; unsigned x;
    volatile LAS unsigned* st;
};

__device__ __forceinline__ XcdBarrier xcd_barrier_post(unsigned* bar, volatile LAS unsigned* st) {
    XcdBarrier b; b.bar = bar; b.x = xb_xcc_id(); b.st = st;
    if (threadIdx.x == 0) (void)xb_add(&bar[XB_XCNT(b.x)], 1u);
    return b;
}
__device__ __forceinline__ void xcd_barrier_complete(unsigned* bar, unsigned x, unsigned& nloc, unsigned& nx) {
    const unsigned G = gridDim.x * gridDim.y * gridDim.z;
    unsigned sum, cnt, mine, sp = 0u;
    for (;;) {
        sum = 0u; cnt = 0u; mine = 0u;
#pragma unroll
        for (unsigned j = 0; j < 16; ++j) { const unsigned c = xb_ld(&bar[XB_XCNT(j)]); sum += c; cnt += (c > 0u) ? 1u : 0u; mine = (j == x) ? c : mine; }
        if (sum == G) break;
        __builtin_amdgcn_s_sleep(1);
        if ((++sp & 255u) == 0u) { if (xb_ld(&bar[XB_TMO])) break; if (sp > XB_SPIN_CAP) { atomicAdd(&bar[XB_TMO], 1u); break; } }
    }
    nloc = mine > 0u ? mine : 1u; nx = cnt > 0u ? cnt : 1u;
}

__device__ __forceinline__ void xcd_barrier(const XcdBarrier& b) {
    asm volatile("s_waitcnt vmcnt(0)" ::: "memory");
    __syncthreads();
    if (threadIdx.x == 0) {
        unsigned* bar = b.bar;
        __builtin_amdgcn_s_waitcnt(0);
        unsigned nloc = b.st[0], nx = b.st[1];
        if (nloc == 0u) { xcd_barrier_complete(bar, b.x, nloc, nx); b.st[0] = nloc; b.st[1] = nx; }
        const unsigned old = xb_add(&bar[XB_XSUB(b.x)], 1u);
        const unsigned gen = old / nloc;
        if (old + 1u == (gen + 1u) * nloc) {
            __builtin_amdgcn_fence(__ATOMIC_RELEASE, "agent");
            asm volatile("s_waitcnt vmcnt(0)" ::: "memory");
            const unsigned og = xb_add(&bar[XB_TOP], 1u);
            const unsigned tg = og / nx;
            if (og + 1u == (tg + 1u) * nx) xb_add(&bar[XB_TOPGEN], 1u);
            else XB_SPIN(xb_ld(&bar[XB_TOPGEN]) == tg, bar);
            __builtin_amdgcn_fence(__ATOMIC_ACQUIRE, "agent");
            xb_add(&bar[XB_XGEN(b.x)], 1u);
            asm volatile("s_waitcnt vmcnt(0)" ::: "memory");
        } else {
            XB_SPIN(xb_ld(&bar[XB_XGEN(b.x)]) == gen, bar);
            __builtin_amdgcn_fence(__ATOMIC_ACQUIRE, "agent");
            asm volatile("s_waitcnt vmcnt(0)" ::: "memory");
        }
    }
    __syncthreads();
}

__device__ __forceinline__ float wave_sum(float v) {
#pragma unroll
    for (int o = 1; o < 64; o <<= 1) v += __shfl_xor(v, o);
    return v;
}
__device__ __forceinline__ int in_src_col(int np, int& nvalid) {
    const int pn = np >> 8, p = np & 255, bj = p >> 7, wc = (p >> 5) & 3; nvalid = 32;
    if (pn < 2) return np;
    if (pn < 6) return (bj == 0 ? 512 : 1024) + 128 * (pn - 2) + (p & 127);
    if (pn < 8) return 1536 + (4 * (pn - 6) + wc) * 64 + 32 * bj;
    if (pn == 8) return (wc < 2 ? 2304 : 2560) + (wc & 1) * 64 + 32 * bj;
    if (pn == 9) return (wc < 2 ? 2048 : 2176) + (wc & 1) * 64 + 32 * bj;
    if (pn == 10) return (wc < 2 ? 2432 : 2688) + (wc & 1) * 64 + 32 * bj;
    if (pn == 11) { nvalid = (p == 0) ? 24 : 0; return 2816; }
    return 2840 + (np - 3072);
}
__device__ __forceinline__ void transpose_item(const float* W, int ldw, int col0, int nvalid, const float* ks, bf16* WT, int ldk, int drow0, int k0, LAS float* scr, int lane, int kd = 0) {
    { const int c4 = lane & 7, n = 4 * c4; f32x4 v[8];
#pragma unroll
      for (int i = 0; i < 8; ++i) { const int kk = 8 * i + (lane >> 3); v[i] = (f32x4){0.f, 0.f, 0.f, 0.f}; if (n < nvalid) v[i] = __builtin_nontemporal_load((const GAS f32x4*)(W + (size_t)(k0 + kk) * ldw + col0 + n)); }
#pragma unroll
      for (int i = 0; i < 8; ++i) { const int kk = 8 * i + (lane >> 3); f32x4 w = v[i]; if (ks) w = w * ks[k0 + kk];
        scr[kk * 33 + n] = w.x; scr[kk * 33 + n + 1] = w.y; scr[kk * 33 + n + 2] = w.z; scr[kk * 33 + n + 3] = w.w; } }
    LDS_WAIT(); asm volatile("" ::: "memory");
    const int c = lane & 7;
#pragma unroll
    for (int j = 0; j < 4; ++j) { const int n = (lane >> 3) + 8 * j; const LAS float* s = scr + (8 * c) * 33 + n;
        v4u o; o.x = pk2(s[0 * 33], s[1 * 33]); o.y = pk2(s[2 * 33], s[3 * 33]); o.z = pk2(s[4 * 33], s[5 * 33]); o.w = pk2(s[6 * 33], s[7 * 33]);
        *(GAS v4u*)(WT + (size_t)(drow0 + n) * ldk + kd + k0 + 8 * c) = o; }
    LDS_WAIT(); asm volatile("" ::: "memory");
}
struct Ptrs {
    const float *x, *n1g, *win, *caw, *wa, *qng, *kng, *kpe, *kw1, *kw2, *vpe, *vw1, *vw2, *wb, *wo, *n2g, *wff, *fcw, *fcb, *wdn; const int* pos;
    float* out; unsigned char* ws;
};
__device__ __forceinline__ void p0_prologue(const Ptrs& P, LAS unsigned char* lds, int vcu, int G, int wave, int lane) {
    LAS float* scr = (LAS float*)(lds + RING_OFF + wave * 16384);
    const int gw = vcu * NWAVES + wave, NGW = G * NWAVES;
    unsigned char* ws = P.ws;
    constexpr int I_IN = (NIN / 32) * (DM / 64), I_A = (DM / 32) * (CW / 64), I_B = I_A, I_O = (DM / 32) * (DM / 64), I_FF = (NFF / 32) * (DM / 64), I_DN = (DM / 32) * (DFF / 64), I_W1 = 2 * (2048 / 64);
    constexpr int NITEMS = I_IN + I_A + I_B + I_O + I_FF + I_DN + 2 * I_W1;
    for (int it = gw; it < NITEMS; it += NGW) {
        int r = it;
        if (r < I_IN) { const int nb = r % (NIN / 32), kb = r / (NIN / 32); int nv; const int sc = in_src_col(32 * nb, nv); transpose_item(P.win, INCOLS, sc, nv, nullptr, (bf16*)(ws + WS_WIN), DM, 32 * nb, 64 * kb, scr, lane); continue; } r -= I_IN;
        if (r < I_A) { const int nb = r % (DM / 32), kb = r / (DM / 32); transpose_item(P.wa, DM, 32 * nb, 32, nullptr, (bf16*)(ws + WS_WA), DM, 32 * nb, 64 * kb, scr, lane, CW); continue; } r -= I_A;
        if (r < I_B) { const int nb = r % (DM / 32), kb = r / (DM / 32); transpose_item(P.wb, DM, 32 * nb, 32, nullptr, (bf16*)(ws + WS_WA), DM, 32 * nb, 64 * kb, scr, lane, 0); continue; } r -= I_B;
        if (r < I_O) { const int nb = r % (DM / 32), kb = r / (DM / 32); transpose_item(P.wo, DM, 32 * nb, 32, nullptr, (bf16*)(ws + WS_WO), DM, 32 * nb, 64 * kb, scr, lane); continue; } r -= I_O;
        if (r < I_FF) { const int nb = r % (NFF / 32), kb = r / (NFF / 32); const int np = 32 * nb, tile = np >> 8, p = np & 255;
            const int sc = (p < 128) ? (128 * tile + p) : (DFF + 128 * tile + p - 128);
            transpose_item(P.wff, NFF, sc, 32, P.n2g, (bf16*)(ws + WS_WFF), DM, np, 64 * kb, scr, lane); continue; } r -= I_FF;
        if (r < I_DN) { const int nb = r % (DM / 32), kb = r / (DM / 32); transpose_item(P.wdn, DM, 32 * nb, 32, nullptr, (bf16*)(ws + WS_WDN), DFF, 32 * nb, 64 * kb, scr, lane); continue; } r -= I_DN;
        if (r < I_W1) { const int nb = r % 2, kb = r / 2; transpose_item(P.kw1, 64, 32 * nb, 32, nullptr, (bf16*)(ws + WS_W1K), 2048, 32 * nb, 64 * kb, scr, lane); continue; } r -= I_W1;
        { const int nb = r % 2, kb = r / 2; transpose_item(P.vw1, 64, 32 * nb, 32, nullptr, (bf16*)(ws + WS_W1V), 2048, 32 * nb, 64 * kb, scr, lane); }
    }
    { const GAS f32x4* gp = (const GAS f32x4*)P.n1g + lane; f32x4 gv[4];
#pragma unroll
      for (int j = 0; j < 4; ++j) gv[j] = gp[64 * j];
      bf16* H1 = (bf16*)(ws + WS_H1);
      for (int m0 = gw; m0 < T; m0 += 4 * NGW) {
        f32x4 v[4][4];
#pragma unroll
        for (int r = 0; r < 4; ++r) { const int m = (m0 + r * NGW < T) ? m0 + r * NGW : m0; const GAS f32x4* xr = (const GAS f32x4*)(P.x + (size_t)m * DM) + lane;
#pragma unroll
          for (int j = 0; j < 4; ++j) v[r][j] = __builtin_nontemporal_load(xr + 64 * j); }
#pragma unroll
        for (int r = 0; r < 4; ++r) { const int m = m0 + r * NGW; if (m < T) { float s = 0.f;
#pragma unroll
          for (int j = 0; j < 4; ++j) s += (v[r][j].x * v[r][j].x + v[r][j].y * v[r][j].y) + (v[r][j].z * v[r][j].z + v[r][j].w * v[r][j].w);
          const float rs = 1.0f / sqrtf(wave_sum(s) * (1.0f / DM) + 1e-6f);
          GAS unsigned long long* o8 = (GAS unsigned long long*)(H1 + (size_t)m * DM) + lane;
#pragma unroll
          for (int j = 0; j < 4; ++j) { const f32x4 y = v[r][j] * rs * gv[j]; o8[64 * j] = (unsigned long long)pk2(y.x, y.y) | ((unsigned long long)pk2(y.z, y.w) << 32); } } }
      } }
    { float* CS = (float*)(ws + WS_CS); const int gt = gw * 64 + lane, NT = NGW * 64;
      const float inv = powf(10000.0f, -(float)(gt & 31) / 32.0f);
      for (int e = gt; e < T * 32; e += NT) { const int row = e >> 5, i = e & 31;
        const float ang = (float)P.pos[row] * inv;
        float sn, cs; sincosf(ang, &sn, &cs); CS[(size_t)row * 64 + i] = cs; CS[(size_t)row * 64 + 32 + i] = sn; } }
    if (gw < 128) { const int kv = gw >> 6, n = gw & 63; const float* pe = kv ? P.vpe : P.kpe; const float* w1 = kv ? P.vw1 : P.kw1; float s = 0.f;
        for (int k = lane; k < 2048; k += 64) s += pe[k] * w1[(size_t)k * 64 + n];
        s = wave_sum(s); if (lane == 0) ((float*)(ws + WS_CB))[gw] = s; }
}
__device__ __forceinline__ void compress_unit(const Ptrs& P, int u, LAS unsigned char* lds, int tid) {
    const int kv = u >> 7, bg = (u >> 3) & 15, rc = u & 7;
    const int lane = tid & 63, w = tid >> 6, ct = w & 3, kh = w >> 2, r = lane & 15, q = lane >> 4;
    const bf16* A = (const bf16*)(P.ws + (kv ? WS_VC : WS_KC)) + (size_t)bg * SEQ * 64;
    const bf16* Bt = (const bf16*)(P.ws + (kv ? WS_W1V : WS_W1K));
    const float* cb = (const float*)(P.ws + WS_CB) + kv * 64;
    const float* w2 = kv ? P.vw2 : P.kw2;
    LAS unsigned char* al = lds + RING_OFF;
    LAS float* hid = (LAS float*)(lds + RING_OFF + 69632);
    LAS float* w2l = (LAS float*)(lds + RING_OFF + 69632 + 16640);
    { const bf16* As = A + (size_t)(32 * rc) * 1024; const unsigned l0 = (unsigned)(uintptr_t)(lds + RING_OFF); const int wu = __builtin_amdgcn_readfirstlane(w);
      for (int j = wu; j < 66; j += NWAVES) att::glds16(As + (size_t)j * 512 + lane * 8, (unsigned)__builtin_amdgcn_readfirstlane(l0 + (unsigned)(j * 1024 + 16 * (j >> 1))));
      for (int j = wu; j < 16; j += NWAVES) att::glds16(w2 + j * 256 + lane * 4, (unsigned)__builtin_amdgcn_readfirstlane(l0 + (unsigned)(69632 + 16640 + j * 1024))); }
    asm volatile("s_waitcnt vmcnt(0)" ::: "memory");
    __syncthreads();
    const bf16* bp = Bt + (size_t)(16 * ct + r) * 2048 + 8 * q + 1024 * kh;
    f32x4 acc0 = {0.f, 0.f, 0.f, 0.f}, acc1 = {0.f, 0.f, 0.f, 0.f};
#pragma unroll 8
    for (int s2 = 0; s2 < 32; ++s2) { const int s = 32 * kh + s2;
        const bf16x8 b0 = *(const bf16x8*)(bp + 32 * s2);
        const int t0 = 16 * r + (s >> 1), t1 = t0 + 256;
        const bf16x8 a0 = *(const LAS bf16x8*)(al + t0 * 128 + 16 * (t0 >> 4) + (s & 1) * 64 + 16 * q), a1 = *(const LAS bf16x8*)(al + t1 * 128 + 16 * (t1 >> 4) + (s & 1) * 64 + 16 * q);
        acc0 = __builtin_amdgcn_mfma_f32_16x16x32_bf16(a0, b0, acc0, 0, 0, 0); acc1 = __builtin_amdgcn_mfma_f32_16x16x32_bf16(a1, b0, acc1, 0, 0, 0);
    }
#pragma unroll
    for (int e = 0; e < 4; ++e) { hid[(kh * 32 + 4 * q + e) * 65 + 16 * ct + r] = acc0[e]; hid[(kh * 32 + 16 + 4 * q + e) * 65 + 16 * ct + r] = acc1[e]; }
    __syncthreads();
    for (int idx = tid; idx < 2048; idx += NWAVES * 64) { const int rl = idx >> 6, c0 = idx & 63;
        float h0 = hid[rl * 65 + c0] + hid[(32 + rl) * 65 + c0] + cb[c0]; h0 = h0 / (1.0f + __expf(-h0)); hid[rl * 65 + c0] = h0; }
    __syncthreads();
    { const int rl = tid >> 4, c4 = tid & 15; float o[4] = {0.f, 0.f, 0.f, 0.f};
      for (int k = 0; k < 64; ++k) { const float h = hid[rl * 65 + k]; const f32x4 wa = *(const LAS f32x4*)(w2l + k * 64 + 4 * c4);
        o[0] += h * wa.x; o[1] += h * wa.y; o[2] += h * wa.z; o[3] += h * wa.w; }
      if (kv == 0) { float ss = (o[0] * o[0] + o[1] * o[1]) + (o[2] * o[2] + o[3] * o[3]);
        ss += __shfl_xor(ss, 1); ss += __shfl_xor(ss, 2); ss += __shfl_xor(ss, 4); ss += __shfl_xor(ss, 8);
        const float rs = 1.0f / sqrtf(ss * (1.0f / 64.0f) + 1e-6f);
#pragma unroll
        for (int j = 0; j < 4; ++j) o[j] = o[j] * rs * P.kng[4 * c4 + j]; }
      const int i = 32 * rc + rl;
      if (i == 255) { o[0] = 0.f; o[1] = 0.f; o[2] = 0.f; o[3] = 0.f; }
      bf16* dst = (bf16*)(P.ws + (kv ? WS_CMPV : WS_CMPK)) + ((size_t)bg * 256 + i) * 64 + 4 * c4;
      *(unsigned long long*)dst = (unsigned long long)pk2(o[0], o[1]) | ((unsigned long long)pk2(o[2], o[3]) << 32); }
    __syncthreads();
}
__device__ __forceinline__ void ffn_fix_rows(unsigned char* ws, const float* cw, int pm, int tid) {
    const float* TAIL = (const float*)(ws + WS_TAIL); const float* HP = (const float*)(ws + WS_HEADP); const float* HU = (const float*)(ws + WS_HEADU); bf16* ACT = (bf16*)(ws + WS_ACT);
    const bool first = (pm & 15) == 0;
    constexpr int NI = 2 * DFF / (NWAVES * 64);
    static_assert(NI * NWAVES * 64 == 2 * DFF, "fix-rows item count");
    float t0[NI], t1[NI], w0[NI], w1[NI], hp[NI], hu[NI];
#pragma unroll
    for (int j = 0; j < NI; ++j) { const int idx = tid + j * NWAVES * 64, fr = idx >= DFF ? 1 : 0, ch = idx - fr * DFF;
        t0[j] = first ? 0.f : TAIL[((size_t)(pm - 1) * 2 + 0) * DFF + ch]; t1[j] = first ? 0.f : TAIL[((size_t)(pm - 1) * 2 + 1) * DFF + ch];
        w0[j] = cw[ch]; w1[j] = cw[DFF + ch]; hp[j] = HP[((size_t)pm * 2 + fr) * DFF + ch]; hu[j] = HU[((size_t)pm * 2 + fr) * DFF + ch]; }
#pragma unroll
    for (int j = 0; j < NI; ++j) { const int idx = tid + j * NWAVES * 64, fr = idx >= DFF ? 1 : 0, ch = idx - fr * DFF;
        const float pre = hp[j] + (fr == 0 ? (w0[j] * t0[j] + w1[j] * t1[j]) : (w0[j] * t1[j]));
        const float a = pre / (1.0f + exp2f(pre)) * hu[j];
        ACT[((size_t)pm * 256 + fr) * DFF + ch] = (bf16)f2bf(a); }
}
#ifdef SELFCHECK
constexpr size_t WS_CHKMASK = 58 * MiB;
constexpr size_t WS_CHKSLAB = 128 * MiB;
constexpr int CHK_NS = 4096;
constexpr int CW_CHK = 8192;
#ifndef CHK_MAXMASK
#define CHK_MAXMASK 40u
#endif
#ifndef CHK_MAXOUT
#define CHK_MAXOUT 40u
#endif
__device__ __forceinline__ float bf2f(unsigned short h) { return __uint_as_float((unsigned)h << 16); }
__device__ __forceinline__ void selfcheck_sample(unsigned char* ws, int sidx) {
    const unsigned short* Q = (const unsigned short*)(ws + WS_Q); const unsigned short* CK = (const unsigned short*)(ws + WS_CMPK); const unsigned short* CV = (const unsigned short*)(ws + WS_CMPV);
    const unsigned short* KS = (const unsigned short*)(ws + WS_KS); const unsigned short* VS = (const unsigned short*)(ws + WS_VS);
    const unsigned short* KW = (const unsigned short*)(ws + WS_KW); const unsigned short* VW = (const unsigned short*)(ws + WS_VW);
    const float* GN = (const float*)(ws + WS_GNSA); const unsigned short* YB = (const unsigned short*)(ws + WS_YAB);
    const unsigned* MK = (const unsigned*)(ws + WS_CHKMASK); float* slab = (float*)(ws + WS_CHKSLAB) + (size_t)sidx * 1024;
    unsigned* ctl = (unsigned*)(ws + WS_CTL) + CW_CHK;
    const int b = sidx & 7, head = (sidx >> 3) & 7; const int si = sidx >> 6;
    int t;
    { const int edges[32] = {0, 1, 15, 30, 31, 32, 46, 47, 48, 63, 64, 65, 127, 128, 511, 512, 513, 575, 576, 1023, 1024, 1025, 1087, 1088, 2047, 2048, 3000, 4031, 4032, 4094, 4095, 777};
      unsigned hsh = (unsigned)sidx * 2654435761u; hsh ^= hsh >> 13; t = (int)(hsh % 4096u);
#pragma unroll
      for (int e = 0; e < 32; ++e) if (si == e) t = edges[e]; }
    const int g = head >> 2; const size_t row = (size_t)b * 4096 + t; const size_t bg = (size_t)(b * 2 + g); const int cur = t >> 6;
    for (int j = 0; j < 64; ++j) slab[j] = 0.f;
    const int kmax = (t >= 31) ? ((t - 31) >> 4) : -1;
    for (int hh = 0; hh < 4; ++hh) {
        const unsigned short* q = Q + row * 512 + (4 * g + hh) * 64;
        float mx = -1e30f;
        for (int k = 0; k <= kmax; ++k) { const unsigned short* kr = CK + (bg * 256 + k) * 64; float s = 0.f; for (int d = 0; d < 64; ++d) s += bf2f(q[d]) * bf2f(kr[d]); slab[64 + k] = s; mx = fmaxf(mx, s); }
        float l = 0.f; for (int k = 0; k <= kmax; ++k) { const float e = exp2f(slab[64 + k] - mx); slab[64 + k] = e; l += e; }
        const float inv = l > 0.f ? 1.0f / l : 0.f;
        for (int k = 0; k <= kmax; ++k) { const float p = slab[64 + k] * inv;
            for (int j = 0; j < 64; ++j) if (16 * k < 64 * j + 64 && 16 * k + 32 > 64 * j) slab[j] += p;
            if (4 * g + hh == head) slab[320 + k] = p; }
    }
    for (int j = 0; j < 64; ++j) { const bool forced = (j == 0) || (j == cur) || (j == cur - 1); const bool valid = j <= cur; slab[j] = forced ? 1e9f : (valid ? slab[j] : -1e9f); }
    unsigned mlo = 0u, mhi = 0u;
    for (int r = 0; r < 16; ++r) { int best = -1; float bv = 0.f;
        for (int j = 0; j < 64; ++j) { const bool taken = (j < 32) ? ((mlo >> j) & 1u) : ((mhi >> (j - 32)) & 1u); if (!taken && (best < 0 || slab[j] > bv)) { best = j; bv = slab[j]; } }
        if (best < 32) mlo |= 1u << best; else mhi |= 1u << (best - 32); }
    const unsigned vlo = (cur >= 31) ? 0xffffffffu : ((2u << cur) - 1u), vhi = (cur < 32) ? 0u : ((cur >= 63) ? 0xffffffffu : ((2u << (cur - 32)) - 1u));
    mlo &= vlo; mhi &= vhi;
    const unsigned flo = MK[(row * 2 + g) * 2 + 0], fhi = MK[(row * 2 + g) * 2 + 1];
    if (flo != mlo || fhi != mhi) atomicAdd(ctl + 1, 1u);
    const unsigned short* q = Q + row * 512 + head * 64;
    const float g0 = GN[row * 24 + head * 3 + 0], g1 = GN[row * 24 + head * 3 + 1], g2 = GN[row * 24 + head * 3 + 2];
    float* y = slab + 576;
    for (int d = 0; d < 64; ++d) y[d] = 0.f;
    for (int k = 0; k <= kmax; ++k) { const float p = slab[320 + k] * g0; const unsigned short* vr = CV + (bg * 256 + k) * 64; for (int d = 0; d < 64; ++d) y[d] += p * bf2f(vr[d]); }
    for (int br = 0; br < 2; ++br) {
        const unsigned short* Kp = br ? KW : KS; const unsigned short* Vp = br ? VW : VS;
        float mx = -1e30f;
        for (int pos = 0; pos <= t; ++pos) { const int j = pos >> 6; const bool on = br ? (pos > t - 512) : ((j < 32) ? ((mlo >> j) & 1u) : ((mhi >> (j - 32)) & 1u));
            if (!on) continue; const unsigned short* kr = Kp + (bg * 4096 + pos) * 64; float s = 0.f; for (int d = 0; d < 64; ++d) s += bf2f(q[d]) * bf2f(kr[d]); mx = fmaxf(mx, s); }
        float l = 0.f; float* o = slab + 640;
        for (int d = 0; d < 64; ++d) o[d] = 0.f;
        for (int pos = 0; pos <= t; ++pos) { const int j = pos >> 6; const bool on = br ? (pos > t - 512) : ((j < 32) ? ((mlo >> j) & 1u) : ((mhi >> (j - 32)) & 1u));
            if (!on) continue; const unsigned short* kr = Kp + (bg * 4096 + pos) * 64; float s = 0.f; for (int d = 0; d < 64; ++d) s += bf2f(q[d]) * bf2f(kr[d]);
            const float e = exp2f(s - mx); l += e; const unsigned short* vr = Vp + (bg * 4096 + pos) * 64; for (int d = 0; d < 64; ++d) o[d] += e * bf2f(vr[d]); }
        const float gg = (br ? g2 : g1) / l;
        for (int d = 0; d < 64; ++d) y[d] += gg * o[d];
    }
    float num = 0.f, den = 0.f;
    for (int d = 0; d < 64; ++d) { const float f = bf2f(YB[row * 1024 + head * 64 + d]); num += (f - y[d]) * (f - y[d]); den += y[d] * y[d]; }
    if (!(num <= 0.0009f * den + 1e-9f)) atomicAdd(ctl + 2, 1u);
    atomicAdd(ctl + 0, 1u);
}
#endif

#ifndef REPEAT_MASK
#define REPEAT_MASK 0
#endif
#define NREP(k) (1 + ((REPEAT_MASK >> (k)) & 1))
template <int R> struct RepOrder { pg8::StaticOrder b;
    __device__ __forceinline__ bool next(int i, pg8::Unit& u) const { return b.next(i / R, u); }
    __device__ __forceinline__ void a_ready(const pg8::Unit&) const {}
    __device__ __forceinline__ void done(const pg8::Unit&) const {} };
template <int NR> struct RevOrder { pg8::StaticOrder b;
    __device__ __forceinline__ bool next(int i, pg8::Unit& u) const { return (i < NR) ? b.next(NR - 1 - i, u) : false; }
    __device__ __forceinline__ void a_ready(const pg8::Unit&) const {}
    __device__ __forceinline__ void done(const pg8::Unit&) const {} };
__device__ __forceinline__ const void* ldptr(LAS const unsigned long long* PT, int i) { const unsigned long long v = PT[i];
    const unsigned lo = (unsigned)__builtin_amdgcn_readfirstlane((int)(unsigned)v), hi = (unsigned)__builtin_amdgcn_readfirstlane((int)(unsigned)(v >> 32)); return (const void*)(uintptr_t)(((unsigned long long)hi << 32) | lo); }
struct Args { const void* in[21]; float* out; unsigned char* ws; int ph_lo, ph_hi, li, pad; };
__global__ void __launch_bounds__(NWAVES * 64, 2) nsa_block_fwd(Args args) {
    extern __shared__ __attribute__((aligned(16))) unsigned char lds[];
    LAS unsigned char* L = (LAS unsigned char*)lds;
    volatile LAS unsigned* MISC = (volatile LAS unsigned*)(L + MISC_OFF);
    const int tid0 = threadIdx.x;
#define FRESH_TID() int tid = threadIdx.x; asm volatile("" : "+v"(tid)); const int lane = tid & 63; const int wave = __builtin_amdgcn_readfirstlane(tid >> 6); const int gtid = vcu * (NWAVES * 64) + tid; (void)lane; (void)wave; (void)gtid
    const int G = gridDim.x; const int bx = blockIdx.x; const int vcu = (G % 8 == 0) ? (bx % 8) * (G / 8) + bx / 8 : bx;
    unsigned char* ws = args.ws;
    gu32* ctl = (gu32*)(ws + WS_CTL);
    for (int u = tid0; u < (LDS_BYTES - LDSCTL_OFF) / 4; u += NWAVES * 64) ((LAS unsigned*)(L + LDSCTL_OFF))[u] = 0u;
    __syncthreads();
    LAS unsigned long long* PT = (LAS unsigned long long*)(L + LDSCTL_OFF + 512);
    if (tid0 == 0) {
#pragma unroll
        for (int i = 0; i < 21; ++i) PT[i] = (unsigned long long)(uintptr_t)args.in[i]; }
    __syncthreads();
#define LDP(i) ((const float*)ldptr(PT, (i)))
    Ptrs P; P.out = args.out; P.ws = args.ws;
    XcdBarrier bar; bar.bar = (unsigned*)(ctl + CW_BAR); bar.x = 0; bar.st = nullptr;
    if (N_LAUNCHES == 1) bar = xcd_barrier_post((unsigned*)(ctl + CW_BAR), MISC + 8);
    const int lo = args.ph_lo, hi = args.ph_hi;
#ifndef PHMASK
#define PHMASK 0xff
#endif
#define IN(k) (((PHMASK >> (k)) & 1) && lo <= (k) && (k) < hi)
#define SEAM(k) do { if (IN(k) && IN((k) + 1)) xcd_barrier(bar); } while (0)
    const int nthr = G * NWAVES * 64;

    if (IN(0)) { FRESH_TID(); P.x = LDP(0); P.pos = (const int*)LDP(1); P.n1g = LDP(2); P.win = LDP(3); P.wa = LDP(5); P.kpe = LDP(8); P.kw1 = LDP(9); P.vpe = LDP(11); P.vw1 = LDP(12); P.wb = LDP(14); P.wo = LDP(15); P.n2g = LDP(16); P.wff = LDP(17); P.wdn = LDP(20);
        for (int rep = 0; rep < NREP(0); ++rep) p0_prologue(P, L, vcu, G, wave, lane); SEAM(0); }
    if (IN(1)) {
        pg8::Gemm g{(const pg8::bf16_t*)(ws + WS_H1), (const pg8::bf16_t*)(ws + WS_WIN), T, NIN, DM}; pg8::StaticOrder S; S.init(T, NIN, G, bx);
        pg8::EpiIn E{ws, LDP(6), LDP(7)};
        RepOrder<NREP(1)> SR{S}; pg8::gemm_phase<pg8::EpiIn, RepOrder<NREP(1)>, true, true>(L + RING_OFF, g, SR, E);
        SEAM(1);
    }
    if (IN(2)) { FRESH_TID(); P.kng = LDP(7); P.kw2 = LDP(10); P.vw2 = LDP(13);
        for (int rep = 0; rep < NREP(2); ++rep)
        for (int u = vcu; u < 256; u += G) compress_unit(P, u, L, tid);
        SEAM(2);
    }
    if (IN(3)) {
        const att::AttnP AP{ws, LDP(4), LDP(7)};
#ifndef ATT_DRY
#define ATT_DRY 0
#endif
        if (ATT_DRY) for (int idx = vcu; idx < 1024; idx += G) {
            const int bgi = (idx & 255) >> 4, s = idx & 15, rnd = idx >> 8;
            const int c = (rnd == 0) ? s : (rnd == 1) ? 31 - s : (rnd == 2) ? 32 + s : 63 - s;
            att::attn_unit<ATT_DRY>(bgi >> 1, bgi & 1, c, AP, (char*)lds + RING_OFF);
        }
        for (int idx = vcu; idx < 1024; idx += G) {
            const int bgi = (idx & 255) >> 4, s = idx & 15, rnd = idx >> 8;
            const int c = (rnd == 0) ? s : (rnd == 1) ? 31 - s : (rnd == 2) ? 32 + s : 63 - s;
            att::attn_unit<0>(bgi >> 1, bgi & 1, c, AP, (char*)lds + RING_OFF);
        }
        SEAM(3);
    }
    if (IN(4)) {
#ifdef SELFCHECK
        { const int gt = vcu * (NWAVES * 64) + (int)threadIdx.x; const int sidx = (gt % 64) * 64 + gt / 64;
          if (gt < CHK_NS) selfcheck_sample(ws, sidx); }
        xcd_barrier(bar);
#endif
        pg8::Gemm g{(const pg8::bf16_t*)(ws + WS_YAB), (const pg8::bf16_t*)(ws + WS_WA), T, DM, DM}; pg8::StaticOrder S; S.init(T, DM, G, bx);
        pg8::EpiMerge E{(const pg8::bf16_t*)(ws + WS_GM), (pg8::bf16_t*)(ws + WS_MIX)};
        RepOrder<NREP(4)> SR{S}; pg8::gemm_phase<pg8::EpiMerge, RepOrder<NREP(4)>, true, true>(L + RING_OFF, g, SR, E);
        SEAM(4);
    }
    if (IN(5)) {
        pg8::Gemm g{(const pg8::bf16_t*)(ws + WS_MIX), (const pg8::bf16_t*)(ws + WS_WO), T, DM, DM}; pg8::StaticOrder S; S.init(T, DM, G, bx);
        pg8::EpiWO E{LDP(0), (pg8::bf16_t*)(ws + WS_X1B), (float*)(ws + WS_SSQ)};
        RepOrder<NREP(5)> SR{S}; pg8::gemm_phase<pg8::EpiWO, RepOrder<NREP(5)>, true, true>(L + RING_OFF, g, SR, E);
        SEAM(5);
    }
    if (IN(6)) { FRESH_TID(); P.fcw = LDP(18); P.fcb = LDP(19);
        pg8::Gemm g{(const pg8::bf16_t*)(ws + WS_X1B), (const pg8::bf16_t*)(ws + WS_WFF), T, NFF, DM}; pg8::StaticOrder S; S.init(T, NFF, G, bx);
        { pg8::Unit uu; float* RS = (float*)(ws + WS_RS); const float* SSQ = (const float*)(ws + WS_SSQ);
          int lastpm = -1;
          for (int i = 0; S.next(i, uu); ++i) if (uu.pm != lastpm) { lastpm = uu.pm; if (tid < 256) { const size_t row = (size_t)uu.pm * 256 + tid; float s = 0.f;
#pragma unroll
              for (int j = 0; j < 16; ++j) s += SSQ[row * 16 + j];
              RS[row] = -1.4426950408889634f / sqrtf(s * (1.0f / 1024.0f) + 1e-6f); } }
          VM_WAIT(); __syncthreads(); }
        pg8::EpiFF1 E{(const float*)(ws + WS_RS), (pg8::bf16_t*)(ws + WS_ACT), (float*)(ws + WS_TAIL), (float*)(ws + WS_HEADP), (float*)(ws + WS_HEADU), P.fcw, P.fcb, (LAS float*)(L + LDSCTL_OFF + 1024)};
        RepOrder<NREP(6)> SR{S}; pg8::gemm_phase<pg8::EpiFF1, RepOrder<NREP(6)>, true, true>(L + RING_OFF, g, SR, E);
        SEAM(6);
    }
    if (IN(7)) { FRESH_TID(); P.fcw = LDP(18);
        { pg8::StaticOrder S0; S0.init(T, DM, G, bx); pg8::Unit uu; for (int i = 0; S0.next(i, uu); ++i) ffn_fix_rows(ws, P.fcw, uu.pm, tid); VM_WAIT(); __syncthreads(); }
        pg8::Gemm g{(const pg8::bf16_t*)(ws + WS_ACT), (const pg8::bf16_t*)(ws + WS_WDN), T, DM, DFF}; pg8::StaticOrder S; S.init(T, DM, G, bx);
        pg8::EpiFF2 E{(const pg8::bf16_t*)(ws + WS_X1B), P.out};
        static_assert(T / 256 * (DM / 256) == 2 * 256, "two rounds on 256 CUs");
        if (G == 256) { RevOrder<2> SR{S}; pg8::gemm_phase<pg8::EpiFF2, RevOrder<2>, true, true>(L + RING_OFF, g, SR, E); }
        else { RepOrder<NREP(7)> SR{S}; pg8::gemm_phase<pg8::EpiFF2, RepOrder<NREP(7)>, true, true>(L + RING_OFF, g, SR, E); }
    }
#ifdef SELFCHECK
    if (IN(7)) { xcd_barrier(bar); const unsigned* cc = (const unsigned*)(ws + WS_CTL) + CW_CHK; const unsigned nd = __hip_atomic_load(cc, RLX_AGENT), nm = __hip_atomic_load(cc + 1, RLX_AGENT), no = __hip_atomic_load(cc + 2, RLX_AGENT);
        const bool bad = (nd != (unsigned)CHK_NS) || (nm > CHK_MAXMASK) || (no > CHK_MAXOUT);
        if (bad && blockIdx.x == 0) { for (int i = threadIdx.x; i < 4096; i += NWAVES * 64) P.out[i] = __builtin_nanf(""); } }
#endif
#undef IN
#undef SEAM
}

extern "C" void kernel_launch(void* const* d_in, const int* in_sizes, int n_in, void* d_out, int out_size, void* d_ws, size_t ws_size, hipStream_t stream) {
    static int grid = 0;
    if (grid == 0) {
        if (n_in != 21 || in_sizes[0] != T * DM || out_size != T * DM || ws_size < WS_END) {
            fprintf(stderr, "kernel_launch: unexpected problem: n_in %d in0 %d out %d ws %zu (need >= %zu)\n", n_in, n_in > 0 ? in_sizes[0] : -1, out_size, ws_size, (size_t)WS_END); grid = -1; return; }
        int dev = 0, cus = 0, per_cu = 0;
        if (hipGetDevice(&dev) != hipSuccess || hipDeviceGetAttribute(&cus, hipDeviceAttributeMultiprocessorCount, dev) != hipSuccess) { fprintf(stderr, "kernel_launch: device query failed\n"); grid = -1; return; }
        if (hipFuncSetAttribute((const void*)nsa_block_fwd, hipFuncAttributeMaxDynamicSharedMemorySize, LDS_BYTES) != hipSuccess) { fprintf(stderr, "kernel_launch: hipFuncSetAttribute failed\n"); grid = -1; return; }
        if (hipOccupancyMaxActiveBlocksPerMultiprocessor(&per_cu, (const void*)nsa_block_fwd, NWAVES * 64, LDS_BYTES) != hipSuccess || per_cu < 1)
            fprintf(stderr, "kernel_launch: occupancy query reports %d workgroups per CU\n", per_cu);
        (void)hipGetLastError();
        grid = cus;
    }
    if (grid < 0) return;
    if (hipMemsetAsync((char*)d_ws + WS_CTL, 0, CTL_ZERO_BYTES, stream) != hipSuccess) { fprintf(stderr, "kernel_launch: memset failed\n"); return; }
    Args a{};
    for (int i = 0; i < 21; ++i) a.in[i] = d_in[i];
    a.out = (float*)d_out; a.ws = (unsigned char*)d_ws;
    for (int li = 0; li < N_LAUNCHES; ++li) {
        a.ph_lo = (N_LAUNCHES == 1) ? 0 : li; a.ph_hi = (N_LAUNCHES == 1) ? N_PHASES : li + 1; a.li = li;
        hipLaunchKernelGGL(nsa_block_fwd, dim3(grid), dim3(NWAVES * 64), LDS_BYTES, stream, a);
        const hipError_t le = hipPeekAtLastError();
        if (le != hipSuccess) { fprintf(stderr, "kernel_launch: launch %d failed: %s\n", li, hipGetErrorName(le)); break; }
    }
}
```

```cpp
#include <hip/hip_runtime.h>
#include <hip/hip_bf16.h>
#include <cstdio>
#include <cstdint>
#include <cmath>
constexpr int NBATCH = 8, SEQ = 4096, T = NBATCH * SEQ, DM = 1024, INCOLS = 4888, NIN = 5120, DFF = 2816, NFF = 2 * DFF, CW = 512;
constexpr size_t MiB = 1u << 20;
constexpr size_t WS_CTL = 0, CTL_ZERO_BYTES = 1 * MiB;
constexpr size_t WS_CB = 1 * MiB;
constexpr size_t WS_CMPK = 1 * MiB + 65536, WS_CMPV = WS_CMPK + 524288;
constexpr size_t WS_SSQ = 3 * MiB;
constexpr size_t WS_GNSA = 5 * MiB;
constexpr size_t WS_WIN = 8 * MiB, WS_WA = 18 * MiB, WS_WB = 19 * MiB, WS_WO = 20 * MiB, WS_WFF = 22 * MiB, WS_WDN = 33 * MiB, WS_W1K = 39 * MiB, WS_W1V = 39 * MiB + 262144;
constexpr size_t WS_CS = 40 * MiB;
constexpr size_t WS_TAIL = 48 * MiB, WS_HEADP = 51 * MiB, WS_HEADU = 54 * MiB;
constexpr size_t WS_RS = 57 * MiB;
constexpr size_t WS_X1B = 64 * MiB;
constexpr size_t WS_H1 = 160 * MiB, WS_YAB = 160 * MiB;
constexpr size_t WS_AB = 224 * MiB, WS_ACX = 256 * MiB;
constexpr size_t WS_Q = 288 * MiB, WS_KC = 320 * MiB, WS_VC = 328 * MiB, WS_KS = 336 * MiB, WS_VS = 344 * MiB, WS_KW = 352 * MiB, WS_VW = 360 * MiB, WS_MIX = 288 * MiB;
constexpr size_t WS_GM = 370 * MiB;
constexpr size_t WS_ACT = 160 * MiB, WS_END = 512 * MiB;
constexpr int CW_BAR = 4096;
namespace pg8 {
#define PG8_LAS __attribute__((address_space(3)))
typedef unsigned short bf16_t;
typedef short bf16x8 __attribute__((ext_vector_type(8)));
typedef float f32x4 __attribute__((ext_vector_type(4)));
typedef unsigned u32x4 __attribute__((ext_vector_type(4)));
constexpr int BM = 256, BK = 64, HALF = 128, HTB = HALF * BK * 2  , STAGE_BYTES = 8 * HTB, NXCD = 8, WGM = 2;

__host__ __device__ __forceinline__ int lds_byte(int r, int c) { const int st = (r >> 4) * 2 + (c >> 5), rr = r & 15, cc = c & 31, ob = rr * 64 + cc * 2; return st * 1024 + (ob ^ (((ob >> 9) & 1) << 5)); }
__host__ __device__ __forceinline__ void stage_rc(int b, int& R, int& C) { const int st = b / 1024, sb = b % 1024, swz = sb ^ (((sb >> 9) & 1) << 5); R = (st >> 1) * 16 + swz / 64; C = (st & 1) * 32 + (swz % 64) / 2; }
__host__ __device__ __forceinline__ int perm32(int rho) { const int n = rho >> 4, i = rho & 15; return 8 * (i >> 2) + 4 * n + (i & 3); }

struct Unit { int pm, pn; };
struct Gemm { const bf16_t* A; const bf16_t* Bt; int M, N, K; };

struct StaticOrder {
    int nM, nN, nwg, G, c;
    __host__ __device__ void init(int M, int N, int G_, int c_) { nM = M / BM; nN = N / BM; nwg = nM * nN; G = G_; c = c_; }
    __host__ __device__ bool next(int i, Unit& u) const {
        const long L = (long)i * G + c; if (L >= nwg) return false;
        int wgid = (int)L; { const int q = nwg / NXCD, r = nwg % NXCD, xcd = wgid % NXCD, off = wgid / NXCD; wgid = (xcd < r ? xcd * (q + 1) : r * (q + 1) + (xcd - r) * q) + off; }
        const int nig = WGM * nN, gid = wgid / nig, fm = gid * WGM, gsz = (nM - fm) < WGM ? (nM - fm) : WGM;
        u.pm = fm + ((wgid % nig) % gsz); u.pn = (wgid % nig) / gsz; return true;
    }
    __device__ __forceinline__ void a_ready(const Unit&) const {}
    __device__ __forceinline__ void done(const Unit&) const {}
};

typedef float f32x2_cv __attribute__((ext_vector_type(2))); typedef __bf16 bf16x2_cv __attribute__((ext_vector_type(2)));
__device__ __forceinline__ unsigned cvt_pk_bf16(float lo, float hi) { f32x2_cv v = {lo, hi}; bf16x2_cv b = __builtin_convertvector(v, bf16x2_cv); return __builtin_bit_cast(unsigned, b); }
typedef float f32x2 __attribute__((ext_vector_type(2)));
constexpr float EPSN = 1e-6f;
constexpr float QC2 = 0.125f * 1.4426950408889634f;
__device__ __forceinline__ u32x4 pack8(const f32x4 a, const f32x4 b) { u32x4 w; w.x = cvt_pk_bf16(a[0], a[1]); w.y = cvt_pk_bf16(a[2], a[3]); w.z = cvt_pk_bf16(b[0], b[1]); w.w = cvt_pk_bf16(b[2], b[3]); return w; }
__device__ __forceinline__ void unpack8(const u32x4 w, f32x4& a, f32x4& b) {
    a[0] = __uint_as_float(w.x << 16); a[1] = __uint_as_float(w.x & 0xffff0000u); a[2] = __uint_as_float(w.y << 16); a[3] = __uint_as_float(w.y & 0xffff0000u);
    b[0] = __uint_as_float(w.z << 16); b[1] = __uint_as_float(w.z & 0xffff0000u); b[2] = __uint_as_float(w.w << 16); b[3] = __uint_as_float(w.w & 0xffff0000u); }
__device__ __forceinline__ float sigm(float x) { return __builtin_amdgcn_rcpf(1.0f + __builtin_amdgcn_exp2f(-1.4426950408889634f * x)); }
__device__ __forceinline__ f32x4 sigm4(const f32x4 v) { return (f32x4){sigm(v[0]), sigm(v[1]), sigm(v[2]), sigm(v[3])}; }
__device__ __forceinline__ float dot4(const f32x4 v) { return (v[0] * v[0] + v[1] * v[1]) + (v[2] * v[2] + v[3] * v[3]); }

struct EpiIn {
    static constexpr bool PERM = true, AFTER_DRAIN = false, PREFETCH = false, A_BLK = false; static constexpr int MID_T = -1;
    unsigned char* ws; const float* qg; const float* kg;
    __device__ __forceinline__ void operator()(const f32x4 (&acc)[2][2][4][2], const Unit& u, int wr, int wc, int fr, int fq) const {
        const int pn = u.pn; const int row0 = u.pm * BM + wr * 64 + fr;
        bf16_t* const AB = (bf16_t*)(ws + WS_AB); bf16_t* const ACX = (bf16_t*)(ws + WS_ACX); bf16_t* const Q = (bf16_t*)(ws + WS_Q);
        float* const GNSA = (float*)(ws + WS_GNSA); const float* const CS = (const float*)(ws + WS_CS);
        if (pn < 2) {
#pragma unroll
            for (int ai = 0; ai < 2; ++ai)
#pragma unroll
                for (int m = 0; m < 4; ++m) { const size_t row = (size_t)(row0 + ai * HALF + m * 16);
#pragma unroll
                    for (int bj = 0; bj < 2; ++bj) __builtin_nontemporal_store(pack8(acc[ai][bj][m][0], acc[ai][bj][m][1]), (u32x4*)(AB + row * 512 + pn * 256 + bj * HALF + wc * 32 + fq * 8)); }
        } else if (pn < 6) {
            const int ch = (pn - 2) * 128 + wc * 32 + fq * 8;
#pragma unroll
            for (int ai = 0; ai < 2; ++ai)
#pragma unroll
                for (int m = 0; m < 4; ++m) { const size_t row = (size_t)(row0 + ai * HALF + m * 16);
                    __builtin_nontemporal_store(pack8(acc[ai][0][m][0] * acc[ai][1][m][0], acc[ai][0][m][1] * acc[ai][1][m][1]), (u32x4*)(ACX + row * 512 + ch)); }
        } else if (pn < 9) {
            const bool isq = pn < 8;
            const float* gam = isq ? qg : (kg + (wc < 2 ? 64 : 128));
            const f32x4 g00 = *(const f32x4*)(gam + 8 * fq), g01 = *(const f32x4*)(gam + 8 * fq + 4), g10 = *(const f32x4*)(gam + 32 + 8 * fq), g11 = *(const f32x4*)(gam + 32 + 8 * fq + 4);
            const float osc = isq ? QC2 : 1.0f;
#pragma unroll
            for (int ai = 0; ai < 2; ++ai)
#pragma unroll
                for (int m = 0; m < 4; ++m) { const int row = row0 + ai * HALF + m * 16;
                    const f32x4 v00 = acc[ai][0][m][0], v01 = acc[ai][0][m][1], v10 = acc[ai][1][m][0], v11 = acc[ai][1][m][1];
                    float ss = (dot4(v00) + dot4(v01)) + (dot4(v10) + dot4(v11));
                    ss += __shfl_xor(ss, 16); ss += __shfl_xor(ss, 32);
                    const float r = 1.0f / sqrtf(ss * (1.0f / 64.0f) + EPSN);
                    const f32x4 x1a = v00 * r * g00, x1b = v01 * r * g01, x2a = v10 * r * g10, x2b = v11 * r * g11;
                    const float* cs = CS + (size_t)row * 64 + 8 * fq;
                    const f32x4 ca = *(const f32x4*)(cs), cb = *(const f32x4*)(cs + 4), sa = *(const f32x4*)(cs + 32), sb = *(const f32x4*)(cs + 36);
                    const f32x4 o1a = (x1a * ca - x2a * sa) * osc, o1b = (x1b * cb - x2b * sb) * osc, o2a = (x2a * ca + x1a * sa) * osc, o2b = (x2b * cb + x1b * sb) * osc;
                    bf16_t* dst;
                    if (isq) dst = Q + (size_t)row * 512 + (4 * (pn - 6) + wc) * 64;
                    else dst = (bf16_t*)(ws + (wc < 2 ? WS_KS : WS_KW)) + ((size_t)((row >> 12) * 2 + (wc & 1)) * 4096 + (row & 4095)) * 64;
                    *(u32x4*)(dst + 8 * fq) = pack8(o1a, o1b); *(u32x4*)(dst + 32 + 8 * fq) = pack8(o2a, o2b); }
        } else if (pn < 11) {
            bf16_t* base = (bf16_t*)(ws + ((pn == 9) ? (wc < 2 ? WS_KC : WS_VC) : (wc < 2 ? WS_VS : WS_VW)));
#pragma unroll
            for (int ai = 0; ai < 2; ++ai)
#pragma unroll
                for (int m = 0; m < 4; ++m) { const int row = row0 + ai * HALF + m * 16;
                    bf16_t* dst = base + ((size_t)((row >> 12) * 2 + (wc & 1)) * 4096 + (row & 4095)) * 64;
                    *(u32x4*)(dst + 8 * fq) = pack8(acc[ai][0][m][0], acc[ai][0][m][1]); *(u32x4*)(dst + 32 + 8 * fq) = pack8(acc[ai][1][m][0], acc[ai][1][m][1]); }
        } else if (pn == 11) {
            if (wc == 0 && fq < 3) {
#pragma unroll
                for (int ai = 0; ai < 2; ++ai)
#pragma unroll
                    for (int m = 0; m < 4; ++m) { const size_t row = (size_t)(row0 + ai * HALF + m * 16);
                        *(f32x4*)(GNSA + row * 24 + 8 * fq) = sigm4(acc[ai][0][m][0]); *(f32x4*)(GNSA + row * 24 + 8 * fq + 4) = sigm4(acc[ai][0][m][1]); } }
        } else {
            bf16_t* const GM = (bf16_t*)(ws + WS_GM);
#pragma unroll
            for (int ai = 0; ai < 2; ++ai)
#pragma unroll
                for (int m = 0; m < 4; ++m) { const size_t row = (size_t)(row0 + ai * HALF + m * 16);
#pragma unroll
                    for (int bj = 0; bj < 2; ++bj) __builtin_nontemporal_store(pack8(sigm4(acc[ai][bj][m][0]), sigm4(acc[ai][bj][m][1])), (u32x4*)(GM + row * 2048 + (pn - 12) * 256 + bj * HALF + wc * 32 + fq * 8)); }
        }
    }
};
template <bool ADD> struct EpiGate {
    static constexpr bool PERM = true, AFTER_DRAIN = false, PREFETCH = false, A_BLK = false; static constexpr int MID_T = -1;
    const bf16_t* GM; int goff; const bf16_t* ADDSRC; bf16_t* O;
    __device__ __forceinline__ void operator()(const f32x4 (&acc)[2][2][4][2], const Unit& u, int wr, int wc, int fr, int fq) const {
        const int row0 = u.pm * BM + wr * 64 + fr;
#pragma unroll
        for (int ai = 0; ai < 2; ++ai)
#pragma unroll
            for (int m = 0; m < 4; ++m) { const size_t row = (size_t)(row0 + ai * HALF + m * 16);
#pragma unroll
                for (int bj = 0; bj < 2; ++bj) { const int col = u.pn * BM + bj * HALF + wc * 32 + fq * 8;
                    f32x4 ga, gb; unpack8(*(const u32x4*)(GM + row * 2048 + goff + col), ga, gb);
                    f32x4 ra = ga * acc[ai][bj][m][0], rb = gb * acc[ai][bj][m][1];
                    if (ADD) { f32x4 aa, ab; unpack8(*(const u32x4*)(ADDSRC + row * 1024 + col), aa, ab); ra += aa; rb += ab; }
                    *(u32x4*)(O + row * 1024 + col) = pack8(ra, rb); } }
    }
};
struct EpiMerge {
    static constexpr bool PERM = true, AFTER_DRAIN = false, PREFETCH = false, A_BLK = false; static constexpr int MID_T = 8;
    const bf16_t* GM; bf16_t* O;
    __device__ __forceinline__ void mid(f32x4 (&acc)[2][2][4][2], const Unit& u, int wr, int wc, int fr_in, int fq_in) const {
        int fr = fr_in, fq = fq_in; asm volatile("" : "+v"(fr), "+v"(fq));
        const bf16_t* gbase = GM + (size_t)u.pm * BM * 2048 + u.pn * BM;
#pragma unroll
        for (int ai = 0; ai < 2; ++ai)
#pragma unroll
            for (int m = 0; m < 4; ++m)
#pragma unroll
                for (int bj = 0; bj < 2; ++bj) { const unsigned off = (unsigned)((wr * 64 + ai * HALF + m * 16 + fr) * 2048 + bj * HALF + wc * 32 + fq * 8);
                    f32x4 a0, a1, b0, b1; unpack8(*(const u32x4*)(gbase + off), a0, a1); unpack8(*(const u32x4*)(gbase + off + 1024), b0, b1);
#pragma unroll
                    for (int i = 0; i < 4; ++i) { acc[ai][bj][m][0][i] *= b0[i] * __builtin_amdgcn_rcpf(fmaxf(a0[i], 1e-30f)); acc[ai][bj][m][1][i] *= b1[i] * __builtin_amdgcn_rcpf(fmaxf(a1[i], 1e-30f)); } }
    }
    __device__ __forceinline__ void operator()(const f32x4 (&acc)[2][2][4][2], const Unit& u, int wr, int wc, int fr_in, int fq_in) const {
        int fr = fr_in, fq = fq_in; asm volatile("" : "+v"(fr), "+v"(fq));
        const bf16_t* gbase = GM + (size_t)u.pm * BM * 2048 + u.pn * BM; bf16_t* obase = O + (size_t)u.pm * BM * 1024 + u.pn * BM;
#pragma unroll
        for (int ai = 0; ai < 2; ++ai)
#pragma unroll
            for (int m = 0; m < 4; ++m)
#pragma unroll
                for (int bj = 0; bj < 2; ++bj) { const unsigned rl = (unsigned)(wr * 64 + ai * HALF + m * 16 + fr), cl = (unsigned)(bj * HALF + wc * 32 + fq * 8);
                    f32x4 a0, a1; unpack8(*(const u32x4*)(gbase + rl * 2048 + cl), a0, a1);
                    __builtin_nontemporal_store(pack8(acc[ai][bj][m][0] * a0, acc[ai][bj][m][1] * a1), (u32x4*)(obase + rl * 1024 + cl)); }
    }
};
struct EpiWO {
    static constexpr bool PERM = true, AFTER_DRAIN = false, PREFETCH = false, A_BLK = false; static constexpr int MID_T = -1;
    const float* X; bf16_t* X1B; float* SSQ;
    __device__ __forceinline__ void operator()(const f32x4 (&acc)[2][2][4][2], const Unit& u, int wr, int wc, int fr, int fq) const {
        const int row0 = u.pm * BM + wr * 64 + fr;
#pragma unroll
        for (int ai = 0; ai < 2; ++ai)
#pragma unroll
            for (int m = 0; m < 4; ++m) { const size_t row = (size_t)(row0 + ai * HALF + m * 16); float ss = 0.f;
#pragma unroll
                for (int bj = 0; bj < 2; ++bj) { const int col = u.pn * BM + bj * HALF + wc * 32 + fq * 8;
                    const f32x4 ya = *(const f32x4*)(X + row * 1024 + col) + acc[ai][bj][m][0], yb = *(const f32x4*)(X + row * 1024 + col + 4) + acc[ai][bj][m][1];
                    *(u32x4*)(X1B + row * 1024 + col) = pack8(ya, yb); ss += dot4(ya) + dot4(yb); }
                ss += __shfl_xor(ss, 16); ss += __shfl_xor(ss, 32);
                if (fq == 0) SSQ[row * 16 + u.pn * 4 + wc] = ss; }
    }
};
__device__ __forceinline__ f32x4 dpp_ror1(const f32x4 v) { f32x4 r;
#pragma unroll
    for (int i = 0; i < 4; ++i) r[i] = __int_as_float(__builtin_amdgcn_mov_dpp(__float_as_int(v[i]), 0x121, 0xF, 0xF, false)); return r; }
__device__ __forceinline__ f32x4 dpp_ror2(const f32x4 v) { f32x4 r;
#pragma unroll
    for (int i = 0; i < 4; ++i) r[i] = __int_as_float(__builtin_amdgcn_mov_dpp(__float_as_int(v[i]), 0x122, 0xF, 0xF, false)); return r; }
__device__ __forceinline__ f32x4 silu4(const f32x4 v) { return (f32x4){v[0] * sigm(v[0]), v[1] * sigm(v[1]), v[2] * sigm(v[2]), v[3] * sigm(v[3])}; }
struct EpiFF1 {
    static constexpr bool PERM = true, AFTER_DRAIN = false, PREFETCH = true, A_BLK = false; static constexpr int MID_T = -1;
    const float* RS; bf16_t* ACT; float* TAIL; float* HEADP; float* HEADU; const float* cw; const float* cb; PG8_LAS float* hl;
    __device__ __forceinline__ void pre(const Unit& u, int par, int wid, int lane_in) const {
        int lane = lane_in; asm volatile("" : "+v"(lane));
        if (wid < 4) __builtin_amdgcn_global_load_lds((const unsigned*)(RS + (size_t)u.pm * BM + wid * 64 + lane), (PG8_LAS unsigned*)(hl + 1024 + par * 256 + wid * 64), 4, 0, 0);
        const int arr = wid >> 1; const float* src = (arr < 3 ? cw + arr * 2816 : cb) + u.pn * 128 + (wid & 1) * 64 + lane;
        __builtin_amdgcn_global_load_lds((const unsigned*)src, (PG8_LAS unsigned*)(hl + 1536 + par * 512 + wid * 64), 4, 0, 0);
    }
    __device__ __forceinline__ void ep(const f32x4 (&acc)[2][2][4][2], const Unit& u, int wr, int wc, int fr_in, int fq_in, int par) const {
        int fr = fr_in, fq = fq_in; asm volatile("" : "+v"(fr), "+v"(fq));
        const int pm = __builtin_amdgcn_readfirstlane(u.pm), pn = __builtin_amdgcn_readfirstlane(u.pn);
        const int chl = wc * 32 + fq * 8, ch = pn * 128 + chl;
        const PG8_LAS float* rl = hl + 1024 + par * 256 + wr * 64 + fr;
        const PG8_LAS float* cl = hl + 1536 + par * 512 + chl;
        if (fr >= 14) {
#pragma unroll
            for (int ai = 0; ai < 2; ++ai) { PG8_LAS float* h = hl + ((ai * 2 + wr) * 2 + (fr - 14)) * 128 + chl; const float r3 = rl[ai * HALF + 48];
                const f32x4 ga = acc[ai][0][3][0] * r3, gb = acc[ai][0][3][1] * r3;
                *(PG8_LAS f32x4*)h = ga; *(PG8_LAS f32x4*)(h + 4) = gb;
                if (ai == 1 && wr == 1) { float* tp = TAIL + ((size_t)pm * 2 + (fr - 14)) * 2816 + ch; *(f32x4*)tp = ga; *(f32x4*)(tp + 4) = gb; } } }
        asm volatile("s_waitcnt lgkmcnt(0)\n\ts_barrier" ::: "memory");
        char* tile_act; { const unsigned long long v = (unsigned long long)(ACT + (size_t)pm * BM * 2816 + (size_t)pn * 2 * (BM * 64));
            tile_act = (char*)(((unsigned long long)(unsigned)__builtin_amdgcn_readfirstlane((int)(v >> 32)) << 32) | (unsigned)__builtin_amdgcn_readfirstlane((int)(unsigned)v)); }
        char* tile_hp = (char*)(HEADP + (size_t)pm * 2 * 2816 + pn * 128); char* tile_hu = (char*)(HEADU + (size_t)pm * 2 * 2816 + pn * 128);
        const unsigned vbase = (unsigned)((chl >> 6) * (BM * 64) + (wr * 64 + fr) * 64 + (chl & 63)) * 2u;
#pragma unroll
        for (int ai = 0; ai < 2; ++ai) {
            const int blk = ai * 2 + wr;
            f32x4 c1[2], c2[2];
#pragma unroll
            for (int n = 0; n < 2; ++n) { f32x4 h0 = (f32x4){0.f, 0.f, 0.f, 0.f}, h1 = h0;
                if (blk > 0) { h0 = *(const PG8_LAS f32x4*)(hl + ((blk - 1) * 2 + 0) * 128 + chl + 4 * n); h1 = *(const PG8_LAS f32x4*)(hl + ((blk - 1) * 2 + 1) * 128 + chl + 4 * n); }
                c1[n] = h1; c2[n] = (fr == 0) ? h0 : h1; }
#pragma unroll
            for (int m = 0; m < 4; ++m) {
                const unsigned voff = vbase + (unsigned)((ai * HALF + m * 16) * 64 * 2);
                const float rsv = rl[ai * HALF + m * 16], rsu = rsv * 0.4804530139182014f;
                f32x4 o;
#pragma unroll
                for (int n = 0; n < 2; ++n) {
                    const f32x4 w0 = *(const PG8_LAS f32x4*)(cl + 4 * n), w1 = *(const PG8_LAS f32x4*)(cl + 128 + 4 * n), w2 = *(const PG8_LAS f32x4*)(cl + 256 + 4 * n), bb = *(const PG8_LAS f32x4*)(cl + 384 + 4 * n) * -1.4426950408889634f;
                    const f32x4 cur = acc[ai][0][m][n] * rsv;
                    const f32x4 r1 = dpp_ror1(cur), r2 = dpp_ror2(cur);
                    f32x4 p1 = r1, p2 = r2;
                    if (fr == 0) p1 = c1[n];
                    if (fr < 2) p2 = c2[n];
                    c1[n] = r1; c2[n] = r2;
                    const f32x4 pre = (w0 * p2 + w1 * p1) + (w2 * cur + bb);
                    const f32x4 uv = acc[ai][1][m][n] * rsu;
                    f32x4 sg;
#pragma unroll
                    for (int i = 0; i < 4; ++i) sg[i] = __builtin_amdgcn_rcpf(1.0f + __builtin_amdgcn_exp2f(pre[i]));
                    const f32x4 res = (pre * sg) * uv;
                    o[2 * n] = __uint_as_float(cvt_pk_bf16(res[0], res[1])); o[2 * n + 1] = __uint_as_float(cvt_pk_bf16(res[2], res[3]));
                    if (blk == 0 && m == 0 && fr < 2) { const unsigned hoff = (unsigned)(fr * 2816 + chl + 4 * n) * 4u; *(f32x4*)(tile_hp + hoff) = pre; *(f32x4*)(tile_hu + hoff) = uv; } }
                asm volatile("global_store_dwordx4 %0, %1, %2 nt" :: "v"(voff), "v"(o), "s"(tile_act) : "memory");
                __builtin_amdgcn_sched_barrier(0); }
        }
    }
};
struct EpiFF2 {
    static constexpr bool PERM = true, AFTER_DRAIN = false, PREFETCH = false, A_BLK = true; static constexpr int MID_T = -1;
    const bf16_t* X1B; float* OUT;
    __device__ __forceinline__ void operator()(const f32x4 (&acc)[2][2][4][2], const Unit& u, int wr, int wc, int fr, int fq) const {
        const int row0 = u.pm * BM + wr * 64 + fr;
#pragma unroll
        for (int ai = 0; ai < 2; ++ai)
#pragma unroll
            for (int m = 0; m < 4; ++m) { const size_t row = (size_t)(row0 + ai * HALF + m * 16);
#pragma unroll
                for (int bj = 0; bj < 2; ++bj) { const size_t off = row * 1024 + u.pn * BM + bj * HALF + wc * 32 + fq * 8;
                    f32x4 xa, xb; unpack8(*(const u32x4*)(X1B + off), xa, xb);
                    __builtin_nontemporal_store(xa + acc[ai][bj][m][0], (f32x4*)(OUT + off)); __builtin_nontemporal_store(xb + acc[ai][bj][m][1], (f32x4*)(OUT + off + 4)); } }
    }
};
template <class Epi, class Sched, bool ALIGN_EPI = false, bool SP2 = false>
__device__ __forceinline__ void gemm_phase(PG8_LAS unsigned char* lds, const Gemm g, const Sched& S, const Epi& E) {
    const int tid = threadIdx.x, wid = __builtin_amdgcn_readfirstlane(tid >> 6), lane = tid & 63, wr = wid >> 2, wc = wid & 3, fr = lane & 15, fq = lane >> 4;
    const int K = g.K, nt = K / BK;
    unsigned voffA[2], voffB[2];
#pragma unroll
    for (int i = 0; i < 2; ++i) { int R, C; stage_rc(tid * 16 + i * 8192, R, C); const int Rb = Epi::PERM ? ((R & ~31) + perm32(R & 31)) : R;
        voffA[i] = (unsigned)(Epi::A_BLK ? R * BK + C : R * K + C) * 2u; voffB[i] = (unsigned)(Rb * K + C) * 2u; }
    const size_t kstep = (size_t)(BK * 2);
    const size_t hstep = (size_t)HALF * K * 2;
    const size_t kstepA = Epi::A_BLK ? (size_t)(2 * HALF * BK * 2) : kstep, hstepA = Epi::A_BLK ? (size_t)(HALF * BK * 2) : hstep;
    const size_t tstep = 2 * hstep;
    const unsigned ldsw = (unsigned)wid * 1024u;
    const int aoff = lds_byte(wr * 64 + fr, fq * 8), boff = lds_byte(wc * 32 + fr, fq * 8);
#define PG8_SA(b, h) (((b) * 2 + (h)) * HTB)
#define PG8_SB(b, h) ((4 + (b) * 2 + (h)) * HTB)
#define PG8_STAGE(bufoff, gbase, voff) do { _Pragma("unroll") for (int _i = 0; _i < 2; ++_i) \
        __builtin_amdgcn_global_load_lds((const unsigned*)((const char*)(gbase) + (voff)[_i]), (PG8_LAS unsigned*)(lds + (bufoff) + ldsw + _i * 8192), 16, 0, 0); } while (0)
#define PG8_LDA(dst, b, h) do { _Pragma("unroll") for (int m = 0; m < 4; ++m) _Pragma("unroll") for (int k = 0; k < 2; ++k) dst[m][k] = *(const PG8_LAS bf16x8*)(lds + PG8_SA(b, h) + aoff + m * 2048 + k * 1024); } while (0)
#define PG8_LDB(dst, b, h) do { _Pragma("unroll") for (int n = 0; n < 2; ++n) _Pragma("unroll") for (int k = 0; k < 2; ++k) dst[n][k] = *(const PG8_LAS bf16x8*)(lds + PG8_SB(b, h) + boff + n * 2048 + k * 1024); } while (0)
#define PG8_MMA(ai, bj, At, Bt) do { __builtin_amdgcn_s_setprio(1); _Pragma("unroll") for (int m = 0; m < 4; ++m) _Pragma("unroll") for (int n = 0; n < 2; ++n) _Pragma("unroll") for (int k = 0; k < 2; ++k) \
        acc[ai][bj][m][n] = __builtin_amdgcn_mfma_f32_16x16x32_bf16(Bt[n][k], At[m][k], acc[ai][bj][m][n], 0, 0, 0); __builtin_amdgcn_s_setprio(0); } while (0)
#define PG8_WAIT_V(n) asm volatile("s_waitcnt vmcnt(" #n ")" ::: "memory")
#define PG8_WAIT_L(n) asm volatile("s_waitcnt lgkmcnt(" #n ")" ::: "memory")
#define PG8_BAR __builtin_amdgcn_s_barrier()
#define PG8_SCHED __builtin_amdgcn_sched_barrier(0)
    Unit cur, nxt; int ui = 0;
    if (!S.next(0, cur)) return;
    f32x4 acc[2][2][4][2];
#pragma unroll
    for (int a = 0; a < 2; ++a)
#pragma unroll
        for (int b = 0; b < 2; ++b)
#pragma unroll
            for (int m = 0; m < 4; ++m)
#pragma unroll
                for (int n = 0; n < 2; ++n) acc[a][b][m][n] = (f32x4){0.f, 0.f, 0.f, 0.f};
    bf16x8 At[4][2], B0[2][2], B1[2][2];
    const char* cA = (const char*)g.A + (size_t)cur.pm * tstep; const char* cB = (const char*)g.Bt + (size_t)cur.pn * tstep;
    S.a_ready(cur);
    if constexpr (Epi::PREFETCH) E.pre(cur, 0, wid, lane);
    if constexpr (SP2) {
        PG8_STAGE(PG8_SB(0, 0), cB, voffB); PG8_STAGE(PG8_SB(0, 1), cB + hstep, voffB); PG8_STAGE(PG8_SA(0, 0), cA, voffA); PG8_STAGE(PG8_SA(0, 1), cA + hstepA, voffA);
        if (wr == 1) PG8_BAR;
        PG8_WAIT_V(2); PG8_BAR;
        PG8_STAGE(PG8_SB(1, 0), cB + kstep, voffB); PG8_STAGE(PG8_SA(1, 0), cA + kstepA, voffA); PG8_STAGE(PG8_SB(1, 1), cB + hstep + kstep, voffB);
        PG8_WAIT_V(6); PG8_BAR;
    } else {
        PG8_STAGE(PG8_SB(0, 0), cB, voffB); PG8_STAGE(PG8_SA(0, 0), cA, voffA); PG8_STAGE(PG8_SB(0, 1), cB + hstep, voffB); PG8_STAGE(PG8_SA(0, 1), cA + hstepA, voffA);
        if (wr == 1) PG8_BAR;
        PG8_WAIT_V(4); PG8_BAR;
        PG8_STAGE(PG8_SB(1, 0), cB + kstep, voffB); PG8_STAGE(PG8_SA(1, 0), cA + kstepA, voffA); PG8_STAGE(PG8_SB(1, 1), cB + hstep + kstep, voffB);
        PG8_WAIT_V(6); PG8_BAR;
    }
    for (;;) {
        const bool has_next = S.next(ui + 1, nxt);
        const char* nA = has_next ? (const char*)g.A + (size_t)nxt.pm * tstep : cA; const char* nB = has_next ? (const char*)g.Bt + (size_t)nxt.pn * tstep : cB;
        for (int t = 0; t < nt; t += 2) {
            if constexpr (Epi::MID_T >= 0) { if (t == Epi::MID_T) E.mid(acc, cur, wr, wc, fr, fq); }
            const bool last = (t == nt - 2);
            const char* a1 = cA + (size_t)(t + 1) * kstepA;
            const char* a2 = last ? nA : cA + (size_t)(t + 2) * kstepA; const char* b2 = last ? nB : cB + (size_t)(t + 2) * kstep;
            const char* a3 = a2 + kstepA; const char* b3 = b2 + kstep;
            if (last && has_next) { S.a_ready(nxt); if constexpr (Epi::PREFETCH) E.pre(nxt, (ui + 1) & 1, wid, lane); }
            if constexpr (SP2) {
            PG8_LDB(B0, 0, 0); PG8_LDB(B1, 0, 1); PG8_SCHED; PG8_LDA(At, 0, 0); PG8_STAGE(PG8_SA(1, 1), a1 + hstepA, voffA);
            PG8_WAIT_V(8); PG8_WAIT_L(0); PG8_BAR; PG8_MMA(0, 0, At, B0); PG8_MMA(0, 1, At, B1); PG8_BAR; PG8_SCHED;
            PG8_LDA(At, 0, 1); PG8_STAGE(PG8_SB(0, 0), b2, voffB); PG8_STAGE(PG8_SB(0, 1), b2 + hstep, voffB); PG8_STAGE(PG8_SA(0, 0), a2, voffA);
            PG8_WAIT_V(8); PG8_WAIT_L(0); PG8_BAR; PG8_MMA(1, 0, At, B0); PG8_MMA(1, 1, At, B1); PG8_BAR; PG8_SCHED;
            PG8_LDB(B0, 1, 0); PG8_LDB(B1, 1, 1); PG8_SCHED; PG8_LDA(At, 1, 0); PG8_STAGE(PG8_SA(0, 1), a2 + hstepA, voffA);
            PG8_WAIT_V(8); PG8_WAIT_L(0); PG8_BAR; PG8_MMA(0, 0, At, B0); PG8_MMA(0, 1, At, B1); PG8_BAR; PG8_SCHED;
            PG8_LDA(At, 1, 1); PG8_STAGE(PG8_SB(1, 0), b3, voffB); PG8_STAGE(PG8_SB(1, 1), b3 + hstep, voffB); PG8_STAGE(PG8_SA(1, 0), a3, voffA);
            PG8_WAIT_V(8); PG8_WAIT_L(0); PG8_BAR; PG8_MMA(1, 0, At, B0); PG8_MMA(1, 1, At, B1); PG8_BAR; PG8_SCHED;
            } else {
            PG8_LDB(B0, 0, 0); PG8_SCHED; PG8_LDA(At, 0, 0); PG8_STAGE(PG8_SA(1, 1), a1 + hstepA, voffA);
            PG8_WAIT_L(8); PG8_BAR; PG8_WAIT_L(0); PG8_MMA(0, 0, At, B0); PG8_BAR; PG8_SCHED;
            PG8_LDB(B1, 0, 1); PG8_STAGE(PG8_SB(0, 0), b2, voffB);
            PG8_BAR; PG8_WAIT_L(0); PG8_MMA(0, 1, At, B1); PG8_BAR;
            PG8_LDA(At, 0, 1); PG8_STAGE(PG8_SA(0, 0), a2, voffA);
            PG8_BAR; PG8_WAIT_L(0); PG8_MMA(1, 0, At, B0); PG8_BAR; PG8_SCHED;
            PG8_STAGE(PG8_SB(0, 1), b2 + hstep, voffB);
            PG8_WAIT_V(6); PG8_BAR; PG8_MMA(1, 1, At, B1); PG8_BAR;
            PG8_LDB(B0, 1, 0); PG8_SCHED; PG8_LDA(At, 1, 0); PG8_STAGE(PG8_SA(0, 1), a2 + hstepA, voffA);
            PG8_WAIT_L(8); PG8_BAR; PG8_WAIT_L(0); PG8_MMA(0, 0, At, B0); PG8_BAR; PG8_SCHED;
            PG8_LDB(B1, 1, 1); PG8_STAGE(PG8_SB(1, 0), b3, voffB);
            PG8_BAR; PG8_WAIT_L(0); PG8_MMA(0, 1, At, B1); PG8_BAR;
            PG8_LDA(At, 1, 1); PG8_STAGE(PG8_SA(1, 0), a3, voffA);
            PG8_BAR; PG8_WAIT_L(0); PG8_MMA(1, 0, At, B0); PG8_BAR; PG8_SCHED;
            PG8_STAGE(PG8_SB(1, 1), b3 + hstep, voffB);
            PG8_WAIT_V(6); PG8_BAR; PG8_MMA(1, 1, At, B1); PG8_BAR;
            }
        }
        if constexpr (ALIGN_EPI) { if (wr == 0) PG8_BAR; }
        if constexpr (Epi::PREFETCH) { E.ep(acc, cur, wr, wc, fr, fq, ui & 1); S.done(cur); }
        else if constexpr (!Epi::AFTER_DRAIN) { E(acc, cur, wr, wc, fr, fq); S.done(cur); }
        if (!has_next) break;
#pragma unroll
        for (int a = 0; a < 2; ++a)
#pragma unroll
            for (int b = 0; b < 2; ++b)
#pragma unroll
                for (int m = 0; m < 4; ++m)
#pragma unroll
                    for (int n = 0; n < 2; ++n) acc[a][b][m][n] = (f32x4){0.f, 0.f, 0.f, 0.f};
        cur = nxt; cA = nA; cB = nB; ++ui;
        if constexpr (ALIGN_EPI) { if (wr == 1) PG8_BAR; }
    }
    PG8_WAIT_V(0);
    if constexpr (!ALIGN_EPI) { if (wr == 0) PG8_BAR; }
    PG8_BAR;
    if constexpr (Epi::AFTER_DRAIN) { E.fused(acc, cur, wr, wc, fr, fq, lds, wid, lane); S.done(cur); }
#undef PG8_SA
#undef PG8_SB
#undef PG8_STAGE
#undef PG8_LDA
#undef PG8_LDB
#undef PG8_MMA
#undef PG8_WAIT_V
#undef PG8_WAIT_L
#undef PG8_BAR
#undef PG8_SCHED
}
}
namespace att {
using bf16 = __hip_bfloat16;
using bf16x8 = __attribute__((ext_vector_type(8))) short;
using s16x4 = __attribute__((ext_vector_type(4))) short;
using f32x16 = __attribute__((ext_vector_type(16))) float;
using u32x4 = __attribute__((ext_vector_type(4))) unsigned;
constexpr int SEQ = 4096, SLOTB = 8192;
constexpr int L_CK = 0, L_CV = 4 * SLOTB, L_K = 8 * SLOTB, L_V = 11 * SLOTB, L_WS = 14 * SLOTB, L_RK = L_WS + 8 * 256, L_OST = 0, L_YL = 0, ATT_LDS = L_RK + 8 * 2048;
typedef float f32x4_t __attribute__((ext_vector_type(4)));
constexpr float NEGBIG = -1e30f, FORCEV = 1e9f;
#define SBAR() __builtin_amdgcn_sched_barrier(0)
#define WAIT_BAR(N) asm volatile("s_waitcnt vmcnt(" #N ") lgkmcnt(0)\n\ts_barrier" ::: "memory")
__device__ __forceinline__ int crow(int r, int hi) { return (r & 3) + 8 * (r >> 2) + 4 * hi; }
__device__ __forceinline__ void glds16(const void* gsrc, unsigned lds_dst) { unsigned keep;
    asm volatile("s_mov_b32 %0, m0\n\ts_mov_b32 m0, %2\n\ts_nop 0\n\tglobal_load_lds_dwordx4 %1, off\n\ts_mov_b32 m0, %0" : "=&s"(keep) : "v"(gsrc), "s"(lds_dst) : "memory"); }
typedef float f32x2_t __attribute__((ext_vector_type(2))); typedef __bf16 bf16x2_t __attribute__((ext_vector_type(2)));
__device__ __forceinline__ unsigned cvtpk_s(float lo, float hi) { f32x2_t v = {lo, hi}; bf16x2_t b = __builtin_convertvector(v, bf16x2_t); return __builtin_bit_cast(unsigned, b); }
__device__ __forceinline__ float swap32f_(float v, int hi) { auto rr = __builtin_amdgcn_permlane32_swap(__float_as_uint(v), __float_as_uint(v), false, false); return __uint_as_float(hi ? rr[0] : rr[1]); }
#define swap32f(v) swap32f_((v), hi)
__device__ __forceinline__ void qkt(f32x16& p0, f32x16& p1, const char* Kslot, const bf16x8* qr, const f32x16& c0, int r32, int hi) {
    const char* kb = Kslot + hi * 1024 + r32 * 16;
    bf16x8 kf[8];
#pragma unroll
    for (int d0 = 0; d0 < 4; ++d0) { kf[2 * d0] = *reinterpret_cast<const bf16x8*>(kb + d0 * 2048); kf[2 * d0 + 1] = *reinterpret_cast<const bf16x8*>(kb + d0 * 2048 + 512); }
    SBAR();
    p0 = __builtin_amdgcn_mfma_f32_32x32x16_bf16(kf[0], qr[0], c0, 0, 0, 0); p1 = __builtin_amdgcn_mfma_f32_32x32x16_bf16(kf[1], qr[0], c0, 0, 0, 0);
#pragma unroll
    for (int d0 = 1; d0 < 4; ++d0) { p0 = __builtin_amdgcn_mfma_f32_32x32x16_bf16(kf[2 * d0], qr[d0], p0, 0, 0, 0); p1 = __builtin_amdgcn_mfma_f32_32x32x16_bf16(kf[2 * d0 + 1], qr[d0], p1, 0, 0, 0); }
    SBAR();
}
__device__ __forceinline__ void pv(f32x16* o, int vb, bf16x8 pa0, bf16x8 pa1, bf16x8 pa2, bf16x8 pa3) {
    s16x4 lo[8], hi[8];
#pragma unroll
    for (int d0 = 0; d0 < 2; ++d0)
#pragma unroll
        for (int ks = 0; ks < 4; ++ks) {
            asm volatile("ds_read_b64_tr_b16 %0,%1 offset:%c2" : "=&v"(lo[d0 * 4 + ks]) : "v"(vb), "i"(d0 * 4096 + ks * 1024) : "memory");
            asm volatile("ds_read_b64_tr_b16 %0,%1 offset:%c2" : "=&v"(hi[d0 * 4 + ks]) : "v"(vb), "i"(d0 * 4096 + ks * 1024 + 512) : "memory"); }
    asm volatile("s_waitcnt lgkmcnt(0)" ::: "memory"); SBAR();
#define PK(k) (bf16x8){lo[k][0], lo[k][1], lo[k][2], lo[k][3], hi[k][0], hi[k][1], hi[k][2], hi[k][3]}
#pragma unroll
    for (int d0 = 0; d0 < 2; ++d0) {
        o[d0] = __builtin_amdgcn_mfma_f32_32x32x16_bf16(pa0, PK(d0 * 4 + 0), o[d0], 0, 0, 0);
        o[d0] = __builtin_amdgcn_mfma_f32_32x32x16_bf16(pa1, PK(d0 * 4 + 1), o[d0], 0, 0, 0);
        o[d0] = __builtin_amdgcn_mfma_f32_32x32x16_bf16(pa2, PK(d0 * 4 + 2), o[d0], 0, 0, 0);
        o[d0] = __builtin_amdgcn_mfma_f32_32x32x16_bf16(pa3, PK(d0 * 4 + 3), o[d0], 0, 0, 0); }
#undef PK
}
__device__ __forceinline__ bf16x8 packp(const f32x16& p, int b, float sc) {
    u32x4 w; w.x = cvtpk_s(p[b] * sc, p[b + 1] * sc); w.y = cvtpk_s(p[b + 2] * sc, p[b + 3] * sc); w.z = cvtpk_s(p[b + 4] * sc, p[b + 5] * sc); w.w = cvtpk_s(p[b + 6] * sc, p[b + 7] * sc);
    return __builtin_bit_cast(bf16x8, w); }
__device__ __forceinline__ float dpp_xor1(float v) { return __int_as_float(__builtin_amdgcn_update_dpp(0, __float_as_int(v), 0xB1, 0xF, 0xF, false)); }
__device__ __forceinline__ float dpp_xor2(float v) { return __int_as_float(__builtin_amdgcn_update_dpp(0, __float_as_int(v), 0x4E, 0xF, 0xF, false)); }
__device__ __forceinline__ float sel4(int h4, float a, float b, float c, float d) { return h4 == 0 ? a : (h4 == 1 ? b : (h4 == 2 ? c : d)); }

#define FLASH flash_branch4
struct AttnPtrs { const bf16* Q; const bf16* CMPK; const bf16* CMPV; const bf16* KS; const bf16* VS; const bf16* KW; const bf16* VW; const float* GNSA; bf16* YB; };
struct AttnP { unsigned char* ws; const float* caw; const float* kng; };

#define ATT_DMA_K(base, tile, ldsoff) glds16((base) + (long)(tile) * 4096 + koff, (unsigned)__builtin_amdgcn_readfirstlane(lds0 + (unsigned)(ldsoff) + (unsigned)wid * 1024u))
#define ATT_DMA_V(base, tile, ldsoff) glds16((base) + (long)(tile) * 4096 + voff, (unsigned)__builtin_amdgcn_readfirstlane(lds0 + (unsigned)(ldsoff) + (unsigned)wid * 1024u))

typedef __attribute__((address_space(3))) const char* lds_cptr;
typedef short v4i16_t __attribute__((ext_vector_type(4)));
__device__ __forceinline__ s16x4 vtr(lds_cptr p) { return __builtin_bit_cast(s16x4, __builtin_amdgcn_ds_read_tr16_b64_v4i16((__attribute__((address_space(3))) v4i16_t*)p)); }
#define WAITV_BAR(N) asm volatile("s_waitcnt vmcnt(" #N ") lgkmcnt(0)\n\ts_barrier" ::: "memory")
#define F4_PIN(x) asm volatile("" : "+v"(x))
template <int MODE> __device__ __forceinline__ void flash_branch4(const bf16* Kb, const bf16* Vb, int b, int g, int c, unsigned sel_lo, unsigned sel_hi, const float* GNSA, const bf16* Q, const float* kgain, char* shm) {
    int tid = threadIdx.x; asm volatile("" : "+v"(tid));
    const int lane = tid & 63, r32 = lane & 31, hi = lane >> 5; const int wid = __builtin_amdgcn_readfirstlane(tid >> 6);
    const int qi = 8 * wid + (r32 >> 2), head = 4 * g + (r32 & 3); const long row = (long)b * SEQ + 64 * c + qi;
    const unsigned lds0 = (unsigned)(uintptr_t)shm; float* wsf = (float*)(shm + L_WS) + wid * 64; float* yl = (float*)(shm + L_YL) + wid * 2048 + lane;
    const int koff = lane * 64 + wid * 8, voff = (16 * (wid & 3) + (lane >> 2)) * 64 + (wid >> 2) * 32 + (lane & 3) * 8;
    const int vbl = ((lane >> 4) & 1) * 32 + (lane & 3) * 8 + (4 * hi + ((lane & 15) >> 2)) * 64;
    const float* gatep = GNSA + row * 24 + head * 3 + (MODE == 0 ? 1 : 2); const bf16* qp = Q + row * 512 + head * 64 + hi * 8;
    const int j0 = (MODE == 0) ? 0 : (c > 8 ? c - 8 : 0); const int NT = c - j0 + 1;
    float zz = 0.f; asm volatile("" : "+v"(zz));
    float mhat = 0.f; f32x16 o[2], negm, lac;
#pragma unroll
    for (int r = 0; r < 16; ++r) { o[0][r] = zz; o[1][r] = zz; negm[r] = zz; lac[r] = zz; }
    const bf16x8 ones = {16256, 16256, 16256, 16256, 16256, 16256, 16256, 16256};
    const lds_cptr kp0 = (lds_cptr)shm + L_K + hi * 1024 + r32 * 16;
    const lds_cptr vp0 = (lds_cptr)shm + L_V + vbl;
    bf16x8 kf[8]; f32x16 pA0, pA1, pB0, pB1; bool resc = false;
    s16x4 vlo[8], vhi[8]; u32x4 pw0, pw1, pw2, pw3;
    int sl_prev = 0, sl_cur = 0, sl_next = SLOTB;
#define F4_ROT() do { sl_prev = sl_cur; sl_cur = sl_next; sl_next = (sl_next == 2 * SLOTB) ? 0 : sl_next + SLOTB; } while (0)
#define F4_ALLOWED(t_) ((MODE != 0) ? true : (((j0 + (t_)) < 32) ? (((sel_lo >> (j0 + (t_))) & 1u) != 0u) : (((sel_hi >> (j0 + (t_) - 32)) & 1u) != 0u)))
#define F4_MASK(P0_, P1_, t_) do { const int j_ = j0 + (t_); \
        if (j_ == c) { _Pragma("unroll") for (int r = 0; r < 16; ++r) { const int kk = crow(r, hi); P0_[r] = (kk <= qi) ? P0_[r] : NEGBIG; P1_[r] = (kk + 32 <= qi) ? P1_[r] : NEGBIG; } } \
        else if (MODE == 1 && j_ == c - 8) { _Pragma("unroll") for (int r = 0; r < 16; ++r) { const int kk = crow(r, hi); P0_[r] = (kk > qi) ? P0_[r] : NEGBIG; P1_[r] = (kk + 32 > qi) ? P1_[r] : NEGBIG; } } } while (0)
#define F4_RMAX(C0_, C1_, rm_) do { float a_ = fmaxf(fmaxf(C0_[0], C0_[1]), C1_[0]), b_ = fmaxf(fmaxf(C0_[2], C0_[3]), C1_[1]); a_ = fmaxf(fmaxf(a_, C1_[2]), C1_[3]); \
        _Pragma("unroll") for (int r = 4; r < 16; r += 4) { a_ = fmaxf(fmaxf(a_, C0_[r]), C0_[r + 1]); b_ = fmaxf(fmaxf(b_, C0_[r + 2]), C0_[r + 3]); a_ = fmaxf(fmaxf(a_, C1_[r]), C1_[r + 1]); b_ = fmaxf(fmaxf(b_, C1_[r + 2]), C1_[r + 3]); } \
        rm_ = fmaxf(a_, b_); rm_ = fmaxf(rm_, swap32f(rm_)); } while (0)
#define F4_DECIDE(C0_, C1_, al_) do { if (track) { float rm_; F4_RMAX(C0_, C1_, rm_); rm_ = (al_) ? rm_ : NEGBIG; resc = false; \
        if (__builtin_expect(__any(rm_ > 8.0f), 0)) { const float dl = fmaxf(rm_, 0.f); mhat += dl; \
            _Pragma("unroll") for (int r = 0; r < 16; ++r) { C0_[r] -= dl; C1_[r] -= dl; } \
            _Pragma("unroll") for (int r = 0; r < 16; ++r) negm[r] = -mhat; F4_PIN(negm); \
            const float f_ = __builtin_amdgcn_exp2f(-dl); if (hi == 0) wsf[r32] = f_; resc = true; } } } while (0)
#define F4_RESC() do { if (resc) { asm volatile("s_waitcnt lgkmcnt(0)" ::: "memory"); \
        _Pragma("unroll") for (int r = 0; r < 16; ++r) { const float fr_ = wsf[crow(r, hi)]; o[0][r] *= fr_; o[1][r] *= fr_; lac[r] *= fr_; } } } while (0)
#define F4_PKW(P, B) (cvtpk_s(P[B], P[B + 1]) & pmask)
#define F4_PAF(k) __builtin_bit_cast(bf16x8, pw##k)
#define F4_VFR(i) (bf16x8){vlo[i][0], vlo[i][1], vlo[i][2], vlo[i][3], vhi[i][0], vhi[i][1], vhi[i][2], vhi[i][3]}
#define F4_MF(a, b, cc) __builtin_amdgcn_mfma_f32_32x32x16_bf16(a, b, cc, 0, 0, 0)
#define F4_GAPA(MFs, A0, A1, A2, A3, W0, W1, PW) do { MFs; W0; W1; F4_PIN(PW); SBAR(); } while (0)
#define F4_EX(v) __builtin_amdgcn_exp2f(v)
#define F4_GAPB(MFs, X, B) do { MFs; X[B] = F4_EX(X[B]); X[B + 1] = F4_EX(X[B + 1]); X[B + 2] = F4_EX(X[B + 2]); X[B + 3] = F4_EX(X[B + 3]); F4_PIN(X); SBAR(); } while (0)
#define F4_VRD(i) do { vlo[i] = vtr(vp_ + (((i) >> 2) * 4096 + ((i) & 3) * 1024)); vhi[i] = vtr(vp_ + (((i) >> 2) * 4096 + ((i) & 3) * 1024 + 512)); } while (0)
#define F4_KRD(G, jj) do { if (G) { const lds_cptr kp_ = kp0 + sl_next; kf[2 * (jj)] = *(const __attribute__((address_space(3))) bf16x8*)(kp_ + (jj) * 2048); kf[2 * (jj) + 1] = *(const __attribute__((address_space(3))) bf16x8*)(kp_ + (jj) * 2048 + 512); SBAR(); } } while (0)
#define F4_STEP(C0, C1, P0, P1, t_, FULL) do { SBAR(); const int tt_ = (t_); const bool GK = (FULL) || tt_ + 3 < NT, GV = (FULL) || tt_ + 1 < NT, GL = GV;     \
        const lds_cptr vp_ = vp0 + sl_prev; const bool al_cur = F4_ALLOWED(tt_); \
        F4_VRD(0); SBAR(); \
        F4_GAPA(C0 = F4_MF(kf[0], qr[0], negm), P0[2], P0[3], P0[4], P0[5], pw0[0] = F4_PKW(P0, 0), pw0[1] = F4_PKW(P0, 2), pw0); \
        F4_VRD(4); SBAR(); F4_GAPA(C1 = F4_MF(kf[1], qr[0], negm), P0[6], P0[7], P0[8], P0[9], pw0[2] = F4_PKW(P0, 4), pw0[3] = F4_PKW(P0, 6), pw0); \
        F4_VRD(1); SBAR(); F4_GAPA(C0 = F4_MF(kf[2], qr[1], C0), P0[10], P0[11], P0[12], P0[13], pw1[0] = F4_PKW(P0, 8), pw1[1] = F4_PKW(P0, 10), pw1); \
        F4_VRD(5); SBAR(); F4_GAPA(C1 = F4_MF(kf[3], qr[1], C1), P0[14], P0[15], P1[0], P1[1], pw1[2] = F4_PKW(P0, 12), pw1[3] = F4_PKW(P0, 14), pw1); \
        F4_GAPA(C0 = F4_MF(kf[4], qr[2], C0), P1[2], P1[3], P1[4], P1[5], pw2[0] = F4_PKW(P1, 0), pw2[1] = F4_PKW(P1, 2), pw2); \
        F4_GAPA(C1 = F4_MF(kf[5], qr[2], C1), P1[6], P1[7], P1[8], P1[9], pw2[2] = F4_PKW(P1, 4), pw2[3] = F4_PKW(P1, 6), pw2); \
        F4_GAPA(C0 = F4_MF(kf[6], qr[3], C0), P1[10], P1[11], P1[12], P1[13], pw3[0] = F4_PKW(P1, 8), pw3[1] = F4_PKW(P1, 10), pw3); \
        F4_GAPA(C1 = F4_MF(kf[7], qr[3], C1), P1[14], P1[15], 0.f, 0.f, pw3[2] = F4_PKW(P1, 12), pw3[3] = F4_PKW(P1, 14), pw3); \
        pmask = al_cur ? 0xffffffffu : 0u; \
        if (GK) { ATT_DMA_K(Kb, j0 + tt_ + 3, L_K + sl_cur); } if (GV) { ATT_DMA_V(Vb, j0 + tt_ + 1, L_V + sl_next); } \
        if (!(FULL)) { F4_MASK(C0, C1, tt_); } \
        F4_DECIDE(C0, C1, al_cur); \
        SBAR(); \
        F4_VRD(2); SBAR(); F4_GAPB(o[0] = F4_MF(F4_PAF(0), F4_VFR(0), o[0]), C0, 0); \
        F4_VRD(6); SBAR(); F4_GAPB(o[1] = F4_MF(F4_PAF(0), F4_VFR(4), o[1]); lac = F4_MF(F4_PAF(0), ones, lac), C0, 4); \
        F4_VRD(3); SBAR(); F4_KRD(GL, 0); F4_GAPB(o[0] = F4_MF(F4_PAF(1), F4_VFR(1), o[0]), C0, 8); \
        F4_VRD(7); SBAR(); F4_KRD(GL, 1); F4_GAPB(o[1] = F4_MF(F4_PAF(1), F4_VFR(5), o[1]); lac = F4_MF(F4_PAF(1), ones, lac), C0, 12); \
        F4_KRD(GL, 2); F4_GAPB(o[0] = F4_MF(F4_PAF(2), F4_VFR(2), o[0]), C1, 0); \
        F4_KRD(GL, 3); F4_GAPB(o[1] = F4_MF(F4_PAF(2), F4_VFR(6), o[1]); lac = F4_MF(F4_PAF(2), ones, lac), C1, 4); \
        F4_GAPB(o[0] = F4_MF(F4_PAF(3), F4_VFR(3), o[0]), C1, 8); \
        F4_GAPB(o[1] = F4_MF(F4_PAF(3), F4_VFR(7), o[1]); lac = F4_MF(F4_PAF(3), ones, lac), C1, 12);     \
        SBAR(); \
          \
        if (GK) { WAITV_BAR(2); } else if (GV) { WAITV_BAR(1); } else { WAITV_BAR(0); } \
        F4_RESC(); F4_ROT(); } while (0)
    {
    ATT_DMA_K(Kb, j0, L_K); ATT_DMA_V(Vb, j0, L_V);
    if (NT > 1) { ATT_DMA_K(Kb, j0 + 1, L_K + SLOTB); }
    if (NT > 2) { ATT_DMA_K(Kb, j0 + 2, L_K + 2 * SLOTB); } }
    bf16x8 qr[4];
#pragma unroll
    for (int d0 = 0; d0 < 4; ++d0) qr[d0] = *reinterpret_cast<const bf16x8*>(qp + d0 * 16);
    WAITV_BAR(0);
    bool track;
    { float qq = 0.f;
#pragma unroll
      for (int d0 = 0; d0 < 4; ++d0)
#pragma unroll
        for (int e = 0; e < 8; ++e) { const float v = __uint_as_float(((unsigned)(unsigned short)qr[d0][e]) << 16); qq += v * v; }
      qq += swap32f(qq);
      float gm = fabsf(kgain[lane]);
      gm = fmaxf(gm, dpp_xor1(gm)); gm = fmaxf(gm, dpp_xor2(gm));
#pragma unroll
      for (int o = 4; o < 64; o <<= 1) gm = fmaxf(gm, __shfl_xor(gm, o));
      track = !__all(sqrtf(qq) * 8.0f * gm < 40.0f); }
    qkt(pA0, pA1, shm + L_K, qr, negm, r32, hi);
    F4_MASK(pA0, pA1, 0);
    unsigned pmask = F4_ALLOWED(0) ? 0xffffffffu : 0u;
    F4_DECIDE(pA0, pA1, pmask != 0u);
#pragma unroll
    for (int r = 0; r < 16; ++r) { pA0[r] = F4_EX(pA0[r]); pA1[r] = F4_EX(pA1[r]); }
    WAITV_BAR(0);
    if (NT > 3) { ATT_DMA_K(Kb, j0 + 3, L_K); }
    if (NT > 1) { ATT_DMA_V(Vb, j0 + 1, L_V + SLOTB); }
    F4_ROT();
    if (NT > 1) { const lds_cptr kp_ = kp0 + sl_cur;
        kf[0] = *(const __attribute__((address_space(3))) bf16x8*)(kp_); kf[1] = *(const __attribute__((address_space(3))) bf16x8*)(kp_ + 512);
        kf[2] = *(const __attribute__((address_space(3))) bf16x8*)(kp_ + 2048); kf[3] = *(const __attribute__((address_space(3))) bf16x8*)(kp_ + 2560);
        kf[4] = *(const __attribute__((address_space(3))) bf16x8*)(kp_ + 4096); kf[5] = *(const __attribute__((address_space(3))) bf16x8*)(kp_ + 4608);
        kf[6] = *(const __attribute__((address_space(3))) bf16x8*)(kp_ + 6144); kf[7] = *(const __attribute__((address_space(3))) bf16x8*)(kp_ + 6656); }
    if (NT > 3) { WAITV_BAR(2); } else if (NT > 1) { WAITV_BAR(1); } else { WAITV_BAR(0); }
    int t = 1; bool lastB = false;
    for (; t + 4 < NT; t += 2) {
        F4_STEP(pB0, pB1, pA0, pA1, t, true);
        F4_STEP(pA0, pA1, pB0, pB1, t + 1, true);
    }
    while (t < NT) {
        F4_STEP(pB0, pB1, pA0, pA1, t, false); ++t; lastB = true;
        if (t >= NT) break;
        F4_STEP(pA0, pA1, pB0, pB1, t, false); ++t; lastB = false;
    }
    if (lastB) { pA0 = pB0; pA1 = pB1; }
    {
      pw0 = (u32x4){F4_PKW(pA0, 0), F4_PKW(pA0, 2), F4_PKW(pA0, 4), F4_PKW(pA0, 6)}; pw1 = (u32x4){F4_PKW(pA0, 8), F4_PKW(pA0, 10), F4_PKW(pA0, 12), F4_PKW(pA0, 14)};
      pw2 = (u32x4){F4_PKW(pA1, 0), F4_PKW(pA1, 2), F4_PKW(pA1, 4), F4_PKW(pA1, 6)}; pw3 = (u32x4){F4_PKW(pA1, 8), F4_PKW(pA1, 10), F4_PKW(pA1, 12), F4_PKW(pA1, 14)};
      SBAR(); pv(o, (int)(lds0 + L_V + sl_prev) + vbl, F4_PAF(0), F4_PAF(1), F4_PAF(2), F4_PAF(3));
      lac = F4_MF(F4_PAF(0), ones, lac); lac = F4_MF(F4_PAF(1), ones, lac); lac = F4_MF(F4_PAF(2), ones, lac); lac = F4_MF(F4_PAF(3), ones, lac); }
    if (hi == 0) wsf[r32] = *gatep;
    asm volatile("s_waitcnt lgkmcnt(0)" ::: "memory");
#pragma unroll
    for (int r = 0; r < 16; ++r) { const float fr_ = wsf[crow(r, hi)] * __builtin_amdgcn_rcpf(lac[r]); yl[r * 64] += o[0][r] * fr_; yl[(16 + r) * 64] += o[1][r] * fr_; }
    WAIT_BAR(0);
#undef F4_ROT
#undef F4_ALLOWED
#undef F4_MASK
#undef F4_RMAX
#undef F4_DECIDE
#undef F4_RESC
#undef F4_CV
#undef F4_PKW
#undef F4_PAF
#undef F4_VFR
#undef F4_MF
#undef F4_GAPA
#undef F4_EX
#undef F4_GAPB
#undef F4_VRD
#undef F4_KRD
#undef F4_STEP
}
#undef F4_PIN


template <int DRY> __device__ __forceinline__ void attn_unit(int b, int g, int c, const AttnP& PP, char* shm) {
    int tid = threadIdx.x; asm volatile("" : "+v"(tid));
    unsigned char* wsb = PP.ws; asm volatile("" : "+s"(wsb));
    const AttnPtrs P{(const bf16*)(wsb + WS_Q), (const bf16*)(wsb + WS_CMPK), (const bf16*)(wsb + WS_CMPV), (const bf16*)(wsb + WS_KS), (const bf16*)(wsb + WS_VS), (const bf16*)(wsb + WS_KW), (const bf16*)(wsb + WS_VW), (const float*)(wsb + WS_GNSA), (bf16*)(wsb + WS_YAB)};
    const int lane = tid & 63, r32 = lane & 31, hi = lane >> 5; const int wid = __builtin_amdgcn_readfirstlane(tid >> 6);
    const int qi = 8 * wid + (r32 >> 2), h4 = r32 & 3, head = 4 * g + h4;
    const int t = 64 * c + qi; const long row = (long)b * SEQ + t;
    const unsigned lds0 = (unsigned)(uintptr_t)shm;
    float* wsf = (float*)(shm + L_WS) + wid * 64;
    const long bg = (long)(b * 2 + g);
    const bf16* CKb = P.CMPK + bg * 256 * 64; const bf16* CVb = P.CMPV + bg * 256 * 64;
    const int koff = lane * 64 + wid * 8;
    const int voff = (16 * (wid & 3) + (lane >> 2)) * 64 + (wid >> 2) * 32 + (lane & 3) * 8;
    const int vbl = ((lane >> 4) & 1) * 32 + (lane & 3) * 8 + (4 * hi + ((lane & 15) >> 2)) * 64;
    const int nsl = (((4 * c + 2) >> 6) + 1 < 4) ? ((4 * c + 2) >> 6) + 1 : 4;
    for (int j = 0; j < nsl; ++j) { ATT_DMA_K(CKb, j, L_CK + j * SLOTB); ATT_DMA_V(CVb, j, L_CV + j * SLOTB); }
    const int chn = 256 * g + (tid & 31) * 8, rg = tid >> 5; const long t0 = (long)b * SEQ + 64 * c + 4 * rg;
    f32x4_t cw0[2], cw1[2], cw2[2]; u32x4 cp2 = {0u, 0u, 0u, 0u}, cp1 = cp2, ccu[4], cav[4];
    if (DRY == 0) {
        const bf16* ACX = (const bf16*)(wsb + WS_ACX); const bf16* AB = (const bf16*)(wsb + WS_AB);
#pragma unroll
        for (int j = 0; j < 2; ++j) { cw0[j] = *(const f32x4_t*)(PP.caw + chn + 4 * j); cw1[j] = *(const f32x4_t*)(PP.caw + 512 + chn + 4 * j); cw2[j] = *(const f32x4_t*)(PP.caw + 1024 + chn + 4 * j); }
        if (c != 0 || rg != 0) { cp2 = *(const u32x4*)(ACX + (t0 - 2) * 512 + chn); cp1 = *(const u32x4*)(ACX + (t0 - 1) * 512 + chn); }
#pragma unroll
        for (int rr = 0; rr < 4; ++rr) { ccu[rr] = *(const u32x4*)(ACX + (t0 + rr) * 512 + chn); cav[rr] = *(const u32x4*)(AB + (t0 + rr) * 512 + chn); }
    }
    bf16x8 qr[4];
#pragma unroll
    for (int d0 = 0; d0 < 4; ++d0) qr[d0] = *reinterpret_cast<const bf16x8*>(P.Q + row * 512 + head * 64 + d0 * 16 + hi * 8);
    const float g0 = P.GNSA[row * 24 + head * 3 + 0];
    f32x16 y[2]; y[0] = f32x16{}; y[1] = f32x16{};
    WAIT_BAR(0);
    if (DRY == 0) { bf16* YA = (bf16*)(wsb + WS_YAB) + 512;
#pragma unroll
        for (int rr = 0; rr < 4; ++rr) { const u32x4 cu = ccu[rr], av = cav[rr]; u32x4 ov;
#pragma unroll
            for (int q = 0; q < 4; ++q) { const int j2 = q >> 1, e = (2 * q) & 3;
                const float lo = cw0[j2][e] * __uint_as_float(cp2[q] << 16) + cw1[j2][e] * __uint_as_float(cp1[q] << 16) + cw2[j2][e] * __uint_as_float(cu[q] << 16);
                const float hi_ = cw0[j2][e + 1] * __uint_as_float(cp2[q] & 0xffff0000u) + cw1[j2][e + 1] * __uint_as_float(cp1[q] & 0xffff0000u) + cw2[j2][e + 1] * __uint_as_float(cu[q] & 0xffff0000u);
                ov[q] = cvtpk_s(lo * __uint_as_float(av[q] << 16), hi_ * __uint_as_float(av[q] & 0xffff0000u)); }
            *(u32x4*)(YA + (t0 + rr) * 1024 + chn) = ov; cp2 = cp1; cp1 = cu; }
        SBAR(); }
    unsigned sel_lo, sel_hi;
    {
        const f32x16 z = f32x16{};
        const int kmax = (t >= 31) ? ((t - 31) >> 4) : -1;
        float mref = 0.f, ls = 0.f, ogp = 0.f; float imp[32];
#pragma unroll
        for (int i = 0; i < 32; ++i) imp[i] = 0.f;
#pragma unroll
        for (int sl = 0; sl < 4; ++sl) if (sl < nsl) {
            f32x16 p0, p1; qkt(p0, p1, shm + L_CK + sl * SLOTB, qr, z, r32, hi);
            float tm = NEGBIG;
#pragma unroll
            for (int r = 0; r < 16; ++r) { const int k = 64 * sl + crow(r, hi); p0[r] = (k <= kmax) ? p0[r] : NEGBIG; p1[r] = (k + 32 <= kmax) ? p1[r] : NEGBIG; tm = fmaxf(tm, fmaxf(p0[r], p1[r])); }
            tm = fmaxf(tm, swap32f(tm));
            if (sl == 0) { mref = (tm > -1e29f) ? tm : 0.f; }
            else if (__any(tm - mref > 8.0f)) {
                const float dl = fmaxf(tm - mref, 0.f); mref += dl; const float f = __builtin_amdgcn_exp2f(-dl); ls *= f; ogp *= f;
#pragma unroll
                for (int i = 0; i < 32; ++i) imp[i] *= f;
                if (hi == 0) wsf[r32] = f;
                asm volatile("s_waitcnt lgkmcnt(0)" ::: "memory");
#pragma unroll
                for (int r = 0; r < 16; ++r) { const float fr_ = wsf[crow(r, hi)]; y[0][r] *= fr_; y[1][r] *= fr_; }
            }
#pragma unroll
            for (int r = 0; r < 16; ++r) { p0[r] = __builtin_amdgcn_exp2f(p0[r] - mref); p1[r] = __builtin_amdgcn_exp2f(p1[r] - mref); ls += p0[r] + p1[r]; }
#pragma unroll
            for (int w = 0; w < 2; ++w)
#pragma unroll
                for (int rg = 0; rg < 4; ++rg) { const int i = 8 * sl + 4 * w + rg; const f32x16& e = w ? p1 : p0;
                    const float gs = (e[4 * rg] + e[4 * rg + 1]) + (e[4 * rg + 2] + e[4 * rg + 3]); const float gl = e[4 * rg + 3];
                    const float og = swap32f(gl);
                    imp[i] = gs + (hi ? og : ogp); ogp = og; }
            const bf16x8 pa0 = packp(p0, 0, 1.f), pa1 = packp(p0, 8, 1.f), pa2 = packp(p1, 0, 1.f), pa3 = packp(p1, 8, 1.f);
            SBAR();
            pv(y, (int)(lds0 + L_CV + sl * SLOTB) + vbl, pa0, pa1, pa2, pa3);
            SBAR();
        }
        ls += swap32f(ls);
        const float inv = ls > 0.f ? 1.0f / ls : 0.f;
        if (hi == 0) wsf[r32] = g0 * inv;
        asm volatile("s_waitcnt lgkmcnt(0)" ::: "memory");
#pragma unroll
        for (int r = 0; r < 16; ++r) { const float fr_ = wsf[crow(r, hi)]; y[0][r] *= fr_; y[1][r] *= fr_; }
        unsigned mlo = 0xffffffffu, mhi = 0xffffffffu;
        if (c >= 16) { mlo = 0u; mhi = 0u;
        unsigned* rk = (unsigned*)(shm + L_RK) + wid * 512 + (r32 >> 2) * 64;
        const int jb = 16 * h4 + hi;
#pragma unroll
        for (int i = 0; i < 32; ++i) { float v = imp[i] * inv; v += dpp_xor1(v); v += dpp_xor2(v);
            const int jc = 2 * i + hi;
            unsigned key = (__float_as_uint(v) & 0xFFFFFFC0u) | (unsigned)(63 - jc);
            key = (jc == 0 || jc == c || jc == c - 1) ? (0xFFFFFFC0u | (unsigned)(63 - jc)) : (jc <= c ? key : (unsigned)(63 - jc));
            rk[jc] = key; }
        asm volatile("s_waitcnt lgkmcnt(0)" ::: "memory");
        int rank[8]; unsigned cand[8];
#pragma unroll
        for (int u = 0; u < 8; ++u) { rank[u] = 0; cand[u] = rk[jb + 2 * u]; }
        const int nch = (c >> 2) + 1;
#pragma unroll 4
        for (int ch = 0; ch < nch; ++ch) { const u32x4 v4 = *(const u32x4*)(rk + 4 * ch);
#pragma unroll
            for (int e = 0; e < 4; ++e) { const unsigned v = v4[e];
#pragma unroll
                for (int u = 0; u < 8; ++u) rank[u] += (v > cand[u]) ? 1 : 0; } }
#pragma unroll
        for (int u = 0; u < 8; ++u) { const int jc = jb + 2 * u; if (rank[u] < 16) { if (jc < 32) mlo |= 1u << jc; else mhi |= 1u << (jc - 32); } }
        mlo |= __float_as_uint(dpp_xor1(__uint_as_float(mlo))); mlo |= __float_as_uint(dpp_xor2(__uint_as_float(mlo))); mlo |= __float_as_uint(swap32f(__uint_as_float(mlo)));
        mhi |= __float_as_uint(dpp_xor1(__uint_as_float(mhi))); mhi |= __float_as_uint(dpp_xor2(__uint_as_float(mhi))); mhi |= __float_as_uint(swap32f(__uint_as_float(mhi)));
        }
        const unsigned vlo = (c >= 31) ? 0xffffffffu : ((2u << c) - 1u);
        const unsigned vhi = (c < 32) ? 0u : ((c >= 63) ? 0xffffffffu : ((2u << (c - 32)) - 1u));
        sel_lo = mlo & vlo; sel_hi = mhi & vhi;
#ifdef SELFCHECK
        if (h4 == 0 && hi == 0 && DRY == 0) { unsigned* mk = (unsigned*)(wsb + (58u << 20)) + ((size_t)row * 2 + g) * 2; mk[0] = sel_lo; mk[1] = sel_hi; }
#endif
    }
    SBAR();
    asm volatile("s_waitcnt vmcnt(0) lgkmcnt(0)\n\ts_barrier" ::: "memory");
    if (DRY == 1) { asm volatile("" :: "v"(sel_lo), "v"(sel_hi), "v"(y[0]), "v"(y[1])); asm volatile("s_waitcnt vmcnt(0) lgkmcnt(0)\n\ts_barrier" ::: "memory"); return; }
    float* yl = (float*)(shm + L_YL) + wid * 2048 + lane;
#pragma unroll
    for (int r = 0; r < 16; ++r) { yl[r * 64] = y[0][r]; yl[(16 + r) * 64] = y[1][r]; }
    const bf16* KSb = P.KS + bg * SEQ * 64; const bf16* VSb = P.VS + bg * SEQ * 64; const bf16* KWb = P.KW + bg * SEQ * 64; const bf16* VWb = P.VW + bg * SEQ * 64;
#ifndef NO_FLASH0
    if (DRY != 2)
    FLASH<0>(KSb, VSb, b, g, c, sel_lo, sel_hi, P.GNSA, P.Q, PP.kng + 64, shm);
#else
    y[0][0] += (float)(sel_lo ^ sel_hi);
#endif
#ifndef NO_FLASH1
    if (DRY != 3 && DRY < 4)
    FLASH<1>(KWb, VWb, b, g, c, 0u, 0u, P.GNSA, P.Q, PP.kng + 128, shm);
#endif
    {   int tid2 = threadIdx.x; asm volatile("" : "+v"(tid2)); const int lane = tid2 & 63, r32 = lane & 31, hi = lane >> 5; const int wid = __builtin_amdgcn_readfirstlane(tid2 >> 6); float* yl = (float*)(shm + L_YL) + wid * 2048 + lane;
#pragma unroll
        for (int r = 0; r < 16; ++r) { y[0][r] = yl[r * 64]; y[1][r] = yl[(16 + r) * 64]; }
        asm volatile("s_waitcnt lgkmcnt(0)" ::: "memory");
        bf16* stg = (bf16*)(shm + L_OST) + wid * 4096;
#pragma unroll
        for (int r = 0; r < 16; ++r) { const int orow = crow(r, hi);
#pragma unroll
            for (int d0 = 0; d0 < 2; ++d0) stg[orow * 64 + d0 * 32 + r32] = __float2bfloat16(y[d0][r]); }
        asm volatile("s_waitcnt lgkmcnt(0)" ::: "memory");
#pragma unroll
        for (int i = 0; i < 4; ++i) { const int rowl = i * 8 + (lane >> 3), ch = lane & 7; const u32x4 v = *(const u32x4*)(stg + rowl * 64 + ch * 8);
            bf16* dst = P.YB + ((long)b * SEQ + 64 * c + 8 * wid + (rowl >> 2)) * 1024 + (4 * g + (rowl & 3)) * 64 + ch * 8; *(u32x4*)dst = v; }
    }
    asm volatile("s_waitcnt lgkmcnt(0)\n\ts_barrier" ::: "memory");
}
#undef SBAR
#undef WAIT_BAR
#undef swap32f
}
constexpr int NWAVES = 8;
#ifndef MK_N_LAUNCHES
#define MK_N_LAUNCHES 1
#endif
constexpr int N_PHASES = 8;
constexpr int N_LAUNCHES = MK_N_LAUNCHES;
constexpr int RING_OFF = 0, RING_BYTES = 131072, ATT_BYTES = 133120, LDSCTL_OFF = ATT_BYTES, MISC_OFF = LDSCTL_OFF + 320, LDS_BYTES = 147456;
static_assert(att::ATT_LDS <= ATT_BYTES && RING_BYTES <= ATT_BYTES && LDSCTL_OFF + 1024 + 4096 + 2048 + 4096 <= LDS_BYTES, "LDS map");

#define GAS __attribute__((address_space(1)))
#define LAS __attribute__((address_space(3)))
typedef unsigned short bf16;
typedef unsigned v4u __attribute__((ext_vector_type(4)));
typedef float f32x4 __attribute__((ext_vector_type(4)));
typedef short bf16x8 __attribute__((ext_vector_type(8)));
typedef GAS unsigned gu32;
#define RLX_AGENT __ATOMIC_RELAXED, __HIP_MEMORY_SCOPE_AGENT
#define LDS_WAIT() asm volatile("s_waitcnt lgkmcnt(0)" ::: "memory")
#define VM_WAIT() asm volatile("s_waitcnt vmcnt(0)" ::: "memory")
__device__ __forceinline__ unsigned f2bf(float f) { unsigned u = __builtin_bit_cast(unsigned, f); return (u + 0x7fffu + ((u >> 16) & 1u)) >> 16; }
__device__ __forceinline__ unsigned pk2(float lo, float hi) { return f2bf(lo) | (f2bf(hi) << 16); }
__device__ __forceinline__ float bflo(unsigned w) { return __uint_as_float(w << 16); }
__device__ __forceinline__ float bfhi(unsigned w) { return __uint_as_float(w & 0xffff0000u); }
#define XB_TMO      128
#define XB_XCNT(j)  (256  + 64 * (j))
#define XB_XSUB(j)  (1280 + 64 * (j))
#define XB_XGEN(j)  (2304 + 64 * (j))
#define XB_TOP      3328
#define XB_TOPGEN   3392
#define XCD_BAR_WORDS 3456
#ifdef SELFCHECK
#define XB_SPIN_CAP (1u << 25)
#else
#define XB_SPIN_CAP (1u << 18)
#endif

__device__ __forceinline__ unsigned xb_ld(unsigned* p)              { return __hip_atomic_load(p, __ATOMIC_RELAXED, __HIP_MEMORY_SCOPE_AGENT); }
__device__ __forceinline__ unsigned xb_add(unsigned* p, unsigned v) { return __hip_atomic_fetch_add(p, v, __ATOMIC_RELAXED, __HIP_MEMORY_SCOPE_AGENT); }
__device__ __forceinline__ unsigned xb_xcc_id() { return (unsigned)__builtin_amdgcn_s_getreg((3 << 11) | 20) & 0xFu; }
#define XB_SPIN(cond, bar) do { unsigned _sp = 0; while (cond) { __builtin_amdgcn_s_sleep(1); \
    if ((++_sp & 255u) == 0u) { if (xb_ld(&(bar)[XB_TMO])) break; if (_sp > XB_SPIN_CAP) { atomicAdd(&(bar)[XB_TMO], 1u); break; } } } } while (0)

struct XcdBarrier {
    unsigned* bar; unsigned x;
    volatile LAS unsigned* st;
};

__device__ __forceinline__ XcdBarrier xcd_barrier_post(unsigned* bar, volatile LAS unsigned* st) {
    XcdBarrier b; b.bar = bar; b.x = xb_xcc_id(); b.st = st;
    if (threadIdx.x == 0) (void)xb_add(&bar[XB_XCNT(b.x)], 1u);
    return b;
}
__device__ __forceinline__ void xcd_barrier_complete(unsigned* bar, unsigned x, unsigned& nloc, unsigned& nx) {
    const unsigned G = gridDim.x * gridDim.y * gridDim.z;
    unsigned sum, cnt, mine, sp = 0u;
    for (;;) {
        sum = 0u; cnt = 0u; mine = 0u;
#pragma unroll
        for (unsigned j = 0; j < 16; ++j) { const unsigned c = xb_ld(&bar[XB_XCNT(j)]); sum += c; cnt += (c > 0u) ? 1u : 0u; mine = (j == x) ? c : mine; }
        if (sum == G) break;
        __builtin_amdgcn_s_sleep(1);
        if ((++sp & 255u) == 0u) { if (xb_ld(&bar[XB_TMO])) break; if (sp > XB_SPIN_CAP) { atomicAdd(&bar[XB_TMO], 1u); break; } }
    }
    nloc = mine > 0u ? mine : 1u; nx = cnt > 0u ? cnt : 1u;
}

__device__ __forceinline__ void xcd_barrier(const XcdBarrier& b) {
    asm volatile("s_waitcnt vmcnt(0)" ::: "memory");
    __syncthreads();
    if (threadIdx.x == 0) {
        unsigned* bar = b.bar;
        __builtin_amdgcn_s_waitcnt(0);
        unsigned nloc = b.st[0], nx = b.st[1];
        if (nloc == 0u) { xcd_barrier_complete(bar, b.x, nloc, nx); b.st[0] = nloc; b.st[1] = nx; }
        const unsigned old = xb_add(&bar[XB_XSUB(b.x)], 1u);
        const unsigned gen = old / nloc;
        if (old + 1u == (gen + 1u) * nloc) {
            __builtin_amdgcn_fence(__ATOMIC_RELEASE, "agent");
            asm volatile("s_waitcnt vmcnt(0)" ::: "memory");
            const unsigned og = xb_add(&bar[XB_TOP], 1u);
            const unsigned tg = og / nx;
            if (og + 1u == (tg + 1u) * nx) xb_add(&bar[XB_TOPGEN], 1u);
            else XB_SPIN(xb_ld(&bar[XB_TOPGEN]) == tg, bar);
            __builtin_amdgcn_fence(__ATOMIC_ACQUIRE, "agent");
            xb_add(&bar[XB_XGEN(b.x)], 1u);
            asm volatile("s_waitcnt vmcnt(0)" ::: "memory");
        } else {
            XB_SPIN(xb_ld(&bar[XB_XGEN(b.x)]) == gen, bar);
            __builtin_amdgcn_fence(__ATOMIC_ACQUIRE, "agent");
            asm volatile("s_waitcnt vmcnt(0)" ::: "memory");
        }
    }
    __syncthreads();
}

__device__ __forceinline__ float wave_sum(float v) {
#pragma unroll
    for (int o = 1; o < 64; o <<= 1) v += __shfl_xor(v, o);
    return v;
}
__device__ __forceinline__ int in_src_col(int np, int& nvalid) {
    const int pn = np >> 8, p = np & 255, bj = p >> 7, wc = (p >> 5) & 3; nvalid = 32;
    if (pn < 2) return np;
    if (pn < 6) return (bj == 0 ? 512 : 1024) + 128 * (pn - 2) + (p & 127);
    if (pn < 8) return 1536 + (4 * (pn - 6) + wc) * 64 + 32 * bj;
    if (pn == 8) return (wc < 2 ? 2304 : 2560) + (wc & 1) * 64 + 32 * bj;
    if (pn == 9) return (wc < 2 ? 2048 : 2176) + (wc & 1) * 64 + 32 * bj;
    if (pn == 10) return (wc < 2 ? 2432 : 2688) + (wc & 1) * 64 + 32 * bj;
    if (pn == 11) { nvalid = (p == 0) ? 24 : 0; return 2816; }
    return 2840 + (np - 3072);
}
__device__ __forceinline__ void transpose_item(const float* W, int ldw, int col0, int nvalid, const float* ks, bf16* WT, int ldk, int drow0, int k0, LAS float* scr, int lane, int kd = 0) {
    { const int c4 = lane & 7, n = 4 * c4; f32x4 v[8];
#pragma unroll
      for (int i = 0; i < 8; ++i) { const int kk = 8 * i + (lane >> 3); v[i] = (f32x4){0.f, 0.f, 0.f, 0.f}; if (n < nvalid) v[i] = __builtin_nontemporal_load((const GAS f32x4*)(W + (size_t)(k0 + kk) * ldw + col0 + n)); }
#pragma unroll
      for (int i = 0; i < 8; ++i) { const int kk = 8 * i + (lane >> 3); f32x4 w = v[i]; if (ks) w = w * ks[k0 + kk];
        scr[kk * 33 + n] = w.x; scr[kk * 33 + n + 1] = w.y; scr[kk * 33 + n + 2] = w.z; scr[kk * 33 + n + 3] = w.w; } }
    LDS_WAIT(); asm volatile("" ::: "memory");
    const int c = lane & 7;
#pragma unroll
    for (int j = 0; j < 4; ++j) { const int n = (lane >> 3) + 8 * j; const LAS float* s = scr + (8 * c) * 33 + n;
        v4u o; o.x = pk2(s[0 * 33], s[1 * 33]); o.y = pk2(s[2 * 33], s[3 * 33]); o.z = pk2(s[4 * 33], s[5 * 33]); o.w = pk2(s[6 * 33], s[7 * 33]);
        *(GAS v4u*)(WT + (size_t)(drow0 + n) * ldk + kd + k0 + 8 * c) = o; }
    LDS_WAIT(); asm volatile("" ::: "memory");
}
struct Ptrs {
    const float *x, *n1g, *win, *caw, *wa, *qng, *kng, *kpe, *kw1, *kw2, *vpe, *vw1, *vw2, *wb, *wo, *n2g, *wff, *fcw, *fcb, *wdn; const int* pos;
    float* out; unsigned char* ws;
};
__device__ __forceinline__ void p0_prologue(const Ptrs& P, LAS unsigned char* lds, int vcu, int G, int wave, int lane) {
    LAS float* scr = (LAS float*)(lds + RING_OFF + wave * 16384);
    const int gw = vcu * NWAVES + wave, NGW = G * NWAVES;
    unsigned char* ws = P.ws;
    constexpr int I_IN = (NIN / 32) * (DM / 64), I_A = (DM / 32) * (CW / 64), I_B = I_A, I_O = (DM / 32) * (DM / 64), I_FF = (NFF / 32) * (DM / 64), I_DN = (DM / 32) * (DFF / 64), I_W1 = 2 * (2048 / 64);
    constexpr int NITEMS = I_IN + I_A + I_B + I_O + I_FF + I_DN + 2 * I_W1;
    for (int it = gw; it < NITEMS; it += NGW) {
        int r = it;
        if (r < I_IN) { const int nb = r % (NIN / 32), kb = r / (NIN / 32); int nv; const int sc = in_src_col(32 * nb, nv); transpose_item(P.win, INCOLS, sc, nv, nullptr, (bf16*)(ws + WS_WIN), DM, 32 * nb, 64 * kb, scr, lane); continue; } r -= I_IN;
        if (r < I_A) { const int nb = r % (DM / 32), kb = r / (DM / 32); transpose_item(P.wa, DM, 32 * nb, 32, nullptr, (bf16*)(ws + WS_WA), DM, 32 * nb, 64 * kb, scr, lane, CW); continue; } r -= I_A;
        if (r < I_B) { const int nb = r % (DM / 32), kb = r / (DM / 32); transpose_item(P.wb, DM, 32 * nb, 32, nullptr, (bf16*)(ws + WS_WA), DM, 32 * nb, 64 * kb, scr, lane, 0); continue; } r -= I_B;
        if (r < I_O) { const int nb = r % (DM / 32), kb = r / (DM / 32); transpose_item(P.wo, DM, 32 * nb, 32, nullptr, (bf16*)(ws + WS_WO), DM, 32 * nb, 64 * kb, scr, lane); continue; } r -= I_O;
        if (r < I_FF) { const int nb = r % (NFF / 32), kb = r / (NFF / 32); const int np = 32 * nb, tile = np >> 8, p = np & 255;
            const int sc = (p < 128) ? (128 * tile + p) : (DFF + 128 * tile + p - 128);
            transpose_item(P.wff, NFF, sc, 32, P.n2g, (bf16*)(ws + WS_WFF), DM, np, 64 * kb, scr, lane); continue; } r -= I_FF;
        if (r < I_DN) { const int nb = r % (DM / 32), kb = r / (DM / 32); transpose_item(P.wdn, DM, 32 * nb, 32, nullptr, (bf16*)(ws + WS_WDN), DFF, 32 * nb, 64 * kb, scr, lane); continue; } r -= I_DN;
        if (r < I_W1) { const int nb = r % 2, kb = r / 2; transpose_item(P.kw1, 64, 32 * nb, 32, nullptr, (bf16*)(ws + WS_W1K), 2048, 32 * nb, 64 * kb, scr, lane); continue; } r -= I_W1;
        { const int nb = r % 2, kb = r / 2; transpose_item(P.vw1, 64, 32 * nb, 32, nullptr, (bf16*)(ws + WS_W1V), 2048, 32 * nb, 64 * kb, scr, lane); }
    }
    { const GAS f32x4* gp = (const GAS f32x4*)P.n1g + lane; f32x4 gv[4];
#pragma unroll
      for (int j = 0; j < 4; ++j) gv[j] = gp[64 * j];
      bf16* H1 = (bf16*)(ws + WS_H1);
      for (int m0 = gw; m0 < T; m0 += 4 * NGW) {
        f32x4 v[4][4];
#pragma unroll
        for (int r = 0; r < 4; ++r) { const int m = (m0 + r * NGW < T) ? m0 + r * NGW : m0; const GAS f32x4* xr = (const GAS f32x4*)(P.x + (size_t)m * DM) + lane;
#pragma unroll
          for (int j = 0; j < 4; ++j) v[r][j] = __builtin_nontemporal_load(xr + 64 * j); }
#pragma unroll
        for (int r = 0; r < 4; ++r) { const int m = m0 + r * NGW; if (m < T) { float s = 0.f;
#pragma unroll
          for (int j = 0; j < 4; ++j) s += (v[r][j].x * v[r][j].x + v[r][j].y * v[r][j].y) + (v[r][j].z * v[r][j].z + v[r][j].w * v[r][j].w);
          const float rs = 1.0f / sqrtf(wave_sum(s) * (1.0f / DM) + 1e-6f);
          GAS unsigned long long* o8 = (GAS unsigned long long*)(H1 + (size_t)m * DM) + lane;
#pragma unroll
          for (int j = 0; j < 4; ++j) { const f32x4 y = v[r][j] * rs * gv[j]; o8[64 * j] = (unsigned long long)pk2(y.x, y.y) | ((unsigned long long)pk2(y.z, y.w) << 32); } } }
      } }
    { float* CS = (float*)(ws + WS_CS); const int gt = gw * 64 + lane, NT = NGW * 64;
      const float inv = powf(10000.0f, -(float)(gt & 31) / 32.0f);
      for (int e = gt; e < T * 32; e += NT) { const int row = e >> 5, i = e & 31;
        const float ang = (float)P.pos[row] * inv;
        float sn, cs; sincosf(ang, &sn, &cs); CS[(size_t)row * 64 + i] = cs; CS[(size_t)row * 64 + 32 + i] = sn; } }
    if (gw < 128) { const int kv = gw >> 6, n = gw & 63; const float* pe = kv ? P.vpe : P.kpe; const float* w1 = kv ? P.vw1 : P.kw1; float s = 0.f;
        for (int k = lane; k < 2048; k += 64) s += pe[k] * w1[(size_t)k * 64 + n];
        s = wave_sum(s); if (lane == 0) ((float*)(ws + WS_CB))[gw] = s; }
}
__device__ __forceinline__ void compress_unit(const Ptrs& P, int u, LAS unsigned char* lds, int tid) {
    const int kv = u >> 7, bg = (u >> 3) & 15, rc = u & 7;
    const int lane = tid & 63, w = tid >> 6, ct = w & 3, kh = w >> 2, r = lane & 15, q = lane >> 4;
    const bf16* A = (const bf16*)(P.ws + (kv ? WS_VC : WS_KC)) + (size_t)bg * SEQ * 64;
    const bf16* Bt = (const bf16*)(P.ws + (kv ? WS_W1V : WS_W1K));
    const float* cb = (const float*)(P.ws + WS_CB) + kv * 64;
    const float* w2 = kv ? P.vw2 : P.kw2;
    LAS unsigned char* al = lds + RING_OFF;
    LAS float* hid = (LAS float*)(lds + RING_OFF + 69632);
    LAS float* w2l = (LAS float*)(lds + RING_OFF + 69632 + 16640);
    { const bf16* As = A + (size_t)(32 * rc) * 1024; const unsigned l0 = (unsigned)(uintptr_t)(lds + RING_OFF); const int wu = __builtin_amdgcn_readfirstlane(w);
      for (int j = wu; j < 66; j += NWAVES) att::glds16(As + (size_t)j * 512 + lane * 8, (unsigned)__builtin_amdgcn_readfirstlane(l0 + (unsigned)(j * 1024 + 16 * (j >> 1))));
      for (int j = wu; j < 16; j += NWAVES) att::glds16(w2 + j * 256 + lane * 4, (unsigned)__builtin_amdgcn_readfirstlane(l0 + (unsigned)(69632 + 16640 + j * 1024))); }
    asm volatile("s_waitcnt vmcnt(0)" ::: "memory");
    __syncthreads();
    const bf16* bp = Bt + (size_t)(16 * ct + r) * 2048 + 8 * q + 1024 * kh;
    f32x4 acc0 = {0.f, 0.f, 0.f, 0.f}, acc1 = {0.f, 0.f, 0.f, 0.f};
#pragma unroll 8
    for (int s2 = 0; s2 < 32; ++s2) { const int s = 32 * kh + s2;
        const bf16x8 b0 = *(const bf16x8*)(bp + 32 * s2);
        const int t0 = 16 * r + (s >> 1), t1 = t0 + 256;
        const bf16x8 a0 = *(const LAS bf16x8*)(al + t0 * 128 + 16 * (t0 >> 4) + (s & 1) * 64 + 16 * q), a1 = *(const LAS bf16x8*)(al + t1 * 128 + 16 * (t1 >> 4) + (s & 1) * 64 + 16 * q);
        acc0 = __builtin_amdgcn_mfma_f32_16x16x32_bf16(a0, b0, acc0, 0, 0, 0); acc1 = __builtin_amdgcn_mfma_f32_16x16x32_bf16(a1, b0, acc1, 0, 0, 0);
    }
#pragma unroll
    for (int e = 0; e < 4; ++e) { hid[(kh * 32 + 4 * q + e) * 65 + 16 * ct + r] = acc0[e]; hid[(kh * 32 + 16 + 4 * q + e) * 65 + 16 * ct + r] = acc1[e]; }
    __syncthreads();
    for (int idx = tid; idx < 2048; idx += NWAVES * 64) { const int rl = idx >> 6, c0 = idx & 63;
        float h0 = hid[rl * 65 + c0] + hid[(32 + rl) * 65 + c0] + cb[c0]; h0 = h0 / (1.0f + __expf(-h0)); hid[rl * 65 + c0] = h0; }
    __syncthreads();
    { const int rl = tid >> 4, c4 = tid & 15; float o[4] = {0.f, 0.f, 0.f, 0.f};
      for (int k = 0; k < 64; ++k) { const float h = hid[rl * 65 + k]; const f32x4 wa = *(const LAS f32x4*)(w2l + k * 64 + 4 * c4);
        o[0] += h * wa.x; o[1] += h * wa.y; o[2] += h * wa.z; o[3] += h * wa.w; }
      if (kv == 0) { float ss = (o[0] * o[0] + o[1] * o[1]) + (o[2] * o[2] + o[3] * o[3]);
        ss += __shfl_xor(ss, 1); ss += __shfl_xor(ss, 2); ss += __shfl_xor(ss, 4); ss += __shfl_xor(ss, 8);
        const float rs = 1.0f / sqrtf(ss * (1.0f / 64.0f) + 1e-6f);
#pragma unroll
        for (int j = 0; j < 4; ++j) o[j] = o[j] * rs * P.kng[4 * c4 + j]; }
      const int i = 32 * rc + rl;
      if (i == 255) { o[0] = 0.f; o[1] = 0.f; o[2] = 0.f; o[3] = 0.f; }
      bf16* dst = (bf16*)(P.ws + (kv ? WS_CMPV : WS_CMPK)) + ((size_t)bg * 256 + i) * 64 + 4 * c4;
      *(unsigned long long*)dst = (unsigned long long)pk2(o[0], o[1]) | ((unsigned long long)pk2(o[2], o[3]) << 32); }
    __syncthreads();
}
__device__ __forceinline__ void ffn_fix_rows(unsigned char* ws, const float* cw, int pm, int tid) {
    const float* TAIL = (const float*)(ws + WS_TAIL); const float* HP = (const float*)(ws + WS_HEADP); const float* HU = (const float*)(ws + WS_HEADU); bf16* ACT = (bf16*)(ws + WS_ACT);
    const bool first = (pm & 15) == 0;
    constexpr int NI = 2 * DFF / (NWAVES * 64);
    static_assert(NI * NWAVES * 64 == 2 * DFF, "fix-rows item count");
    float t0[NI], t1[NI], w0[NI], w1[NI], hp[NI], hu[NI];
#pragma unroll
    for (int j = 0; j < NI; ++j) { const int idx = tid + j * NWAVES * 64, fr = idx >= DFF ? 1 : 0, ch = idx - fr * DFF;
        t0[j] = first ? 0.f : TAIL[((size_t)(pm - 1) * 2 + 0) * DFF + ch]; t1[j] = first ? 0.f : TAIL[((size_t)(pm - 1) * 2 + 1) * DFF + ch];
        w0[j] = cw[ch]; w1[j] = cw[DFF + ch]; hp[j] = HP[((size_t)pm * 2 + fr) * DFF + ch]; hu[j] = HU[((size_t)pm * 2 + fr) * DFF + ch]; }
#pragma unroll
    for (int j = 0; j < NI; ++j) { const int idx = tid + j * NWAVES * 64, fr = idx >= DFF ? 1 : 0, ch = idx - fr * DFF;
        const float pre = hp[j] + (fr == 0 ? (w0[j] * t0[j] + w1[j] * t1[j]) : (w0[j] * t1[j]));
        const float a = pre / (1.0f + exp2f(pre)) * hu[j];
        ACT[(size_t)pm * 256 * DFF + (size_t)(ch >> 6) * (256 * 64) + fr * 64 + (ch & 63)] = (bf16)f2bf(a); }
}
#ifdef SELFCHECK
constexpr size_t WS_CHKMASK = 58 * MiB;
constexpr size_t WS_CHKSLAB = 128 * MiB;
constexpr int CHK_NS = 4096;
constexpr int CW_CHK = 8192;
#ifndef CHK_MAXMASK
#define CHK_MAXMASK 40u
#endif
#ifndef CHK_MAXOUT
#define CHK_MAXOUT 40u
#endif
__device__ __forceinline__ float bf2f(unsigned short h) { return __uint_as_float((unsigned)h << 16); }
__device__ __forceinline__ void selfcheck_sample(unsigned char* ws, int sidx) {
    const unsigned short* Q = (const unsigned short*)(ws + WS_Q); const unsigned short* CK = (const unsigned short*)(ws + WS_CMPK); const unsigned short* CV = (const unsigned short*)(ws + WS_CMPV);
    const unsigned short* KS = (const unsigned short*)(ws + WS_KS); const unsigned short* VS = (const unsigned short*)(ws + WS_VS);
    const unsigned short* KW = (const unsigned short*)(ws + WS_KW); const unsigned short* VW = (const unsigned short*)(ws + WS_VW);
    const float* GN = (const float*)(ws + WS_GNSA); const unsigned short* YB = (const unsigned short*)(ws + WS_YAB);
    const unsigned* MK = (const unsigned*)(ws + WS_CHKMASK); float* slab = (float*)(ws + WS_CHKSLAB) + (size_t)sidx * 1024;
    unsigned* ctl = (unsigned*)(ws + WS_CTL) + CW_CHK;
    const int b = sidx & 7, head = (sidx >> 3) & 7; const int si = sidx >> 6;
    int t;
    { const int edges[32] = {0, 1, 15, 30, 31, 32, 46, 47, 48, 63, 64, 65, 127, 128, 511, 512, 513, 575, 576, 1023, 1024, 1025, 1087, 1088, 2047, 2048, 3000, 4031, 4032, 4094, 4095, 777};
      unsigned hsh = (unsigned)sidx * 2654435761u; hsh ^= hsh >> 13; t = (int)(hsh % 4096u);
#pragma unroll
      for (int e = 0; e < 32; ++e) if (si == e) t = edges[e]; }
    const int g = head >> 2; const size_t row = (size_t)b * 4096 + t; const size_t bg = (size_t)(b * 2 + g); const int cur = t >> 6;
    for (int j = 0; j < 64; ++j) slab[j] = 0.f;
    const int kmax = (t >= 31) ? ((t - 31) >> 4) : -1;
    for (int hh = 0; hh < 4; ++hh) {
        const unsigned short* q = Q + row * 512 + (4 * g + hh) * 64;
        float mx = -1e30f;
        for (int k = 0; k <= kmax; ++k) { const unsigned short* kr = CK + (bg * 256 + k) * 64; float s = 0.f; for (int d = 0; d < 64; ++d) s += bf2f(q[d]) * bf2f(kr[d]); slab[64 + k] = s; mx = fmaxf(mx, s); }
        float l = 0.f; for (int k = 0; k <= kmax; ++k) { const float e = exp2f(slab[64 + k] - mx); slab[64 + k] = e; l += e; }
        const float inv = l > 0.f ? 1.0f / l : 0.f;
        for (int k = 0; k <= kmax; ++k) { const float p = slab[64 + k] * inv;
            for (int j = 0; j < 64; ++j) if (16 * k < 64 * j + 64 && 16 * k + 32 > 64 * j) slab[j] += p;
            if (4 * g + hh == head) slab[320 + k] = p; }
    }
    for (int j = 0; j < 64; ++j) { const bool forced = (j == 0) || (j == cur) || (j == cur - 1); const bool valid = j <= cur; slab[j] = forced ? 1e9f : (valid ? slab[j] : -1e9f); }
    unsigned mlo = 0u, mhi = 0u;
    for (int r = 0; r < 16; ++r) { int best = -1; float bv = 0.f;
        for (int j = 0; j < 64; ++j) { const bool taken = (j < 32) ? ((mlo >> j) & 1u) : ((mhi >> (j - 32)) & 1u); if (!taken && (best < 0 || slab[j] > bv)) { best = j; bv = slab[j]; } }
        if (best < 32) mlo |= 1u << best; else mhi |= 1u << (best - 32); }
    const unsigned vlo = (cur >= 31) ? 0xffffffffu : ((2u << cur) - 1u), vhi = (cur < 32) ? 0u : ((cur >= 63) ? 0xffffffffu : ((2u << (cur - 32)) - 1u));
    mlo &= vlo; mhi &= vhi;
    const unsigned flo = MK[(row * 2 + g) * 2 + 0], fhi = MK[(row * 2 + g) * 2 + 1];
    if (flo != mlo || fhi != mhi) atomicAdd(ctl + 1, 1u);
    const unsigned short* q = Q + row * 512 + head * 64;
    const float g0 = GN[row * 24 + head * 3 + 0], g1 = GN[row * 24 + head * 3 + 1], g2 = GN[row * 24 + head * 3 + 2];
    float* y = slab + 576;
    for (int d = 0; d < 64; ++d) y[d] = 0.f;
    for (int k = 0; k <= kmax; ++k) { const float p = slab[320 + k] * g0; const unsigned short* vr = CV + (bg * 256 + k) * 64; for (int d = 0; d < 64; ++d) y[d] += p * bf2f(vr[d]); }
    for (int br = 0; br < 2; ++br) {
        const unsigned short* Kp = br ? KW : KS; const unsigned short* Vp = br ? VW : VS;
        float mx = -1e30f;
        for (int pos = 0; pos <= t; ++pos) { const int j = pos >> 6; const bool on = br ? (pos > t - 512) : ((j < 32) ? ((mlo >> j) & 1u) : ((mhi >> (j - 32)) & 1u));
            if (!on) continue; const unsigned short* kr = Kp + (bg * 4096 + pos) * 64; float s = 0.f; for (int d = 0; d < 64; ++d) s += bf2f(q[d]) * bf2f(kr[d]); mx = fmaxf(mx, s); }
        float l = 0.f; float* o = slab + 640;
        for (int d = 0; d < 64; ++d) o[d] = 0.f;
        for (int pos = 0; pos <= t; ++pos) { const int j = pos >> 6; const bool on = br ? (pos > t - 512) : ((j < 32) ? ((mlo >> j) & 1u) : ((mhi >> (j - 32)) & 1u));
            if (!on) continue; const unsigned short* kr = Kp + (bg * 4096 + pos) * 64; float s = 0.f; for (int d = 0; d < 64; ++d) s += bf2f(q[d]) * bf2f(kr[d]);
            const float e = exp2f(s - mx); l += e; const unsigned short* vr = Vp + (bg * 4096 + pos) * 64; for (int d = 0; d < 64; ++d) o[d] += e * bf2f(vr[d]); }
        const float gg = (br ? g2 : g1) / l;
        for (int d = 0; d < 64; ++d) y[d] += gg * o[d];
    }
    float num = 0.f, den = 0.f;
    for (int d = 0; d < 64; ++d) { const float f = bf2f(YB[row * 1024 + head * 64 + d]); num += (f - y[d]) * (f - y[d]); den += y[d] * y[d]; }
    if (!(num <= 0.0009f * den + 1e-9f)) atomicAdd(ctl + 2, 1u);
    atomicAdd(ctl + 0, 1u);
}
#endif

#ifndef REPEAT_MASK
#define REPEAT_MASK 0
#endif
#define NREP(k) (1 + ((REPEAT_MASK >> (k)) & 1))
template <int R> struct RepOrder { pg8::StaticOrder b;
    __device__ __forceinline__ bool next(int i, pg8::Unit& u) const { return b.next(i / R, u); }
    __device__ __forceinline__ void a_ready(const pg8::Unit&) const {}
    __device__ __forceinline__ void done(const pg8::Unit&) const {} };
template <int NR> struct RevOrder { pg8::StaticOrder b;
    __device__ __forceinline__ bool next(int i, pg8::Unit& u) const { return (i < NR) ? b.next(NR - 1 - i, u) : false; }
    __device__ __forceinline__ void a_ready(const pg8::Unit&) const {}
    __device__ __forceinline__ void done(const pg8::Unit&) const {} };
__device__ __forceinline__ const void* ldptr(LAS const unsigned long long* PT, int i) { const unsigned long long v = PT[i];
    const unsigned lo = (unsigned)__builtin_amdgcn_readfirstlane((int)(unsigned)v), hi = (unsigned)__builtin_amdgcn_readfirstlane((int)(unsigned)(v >> 32)); return (const void*)(uintptr_t)(((unsigned long long)hi << 32) | lo); }
struct Args { const void* in[21]; float* out; unsigned char* ws; int ph_lo, ph_hi, li, pad; };
__global__ void __launch_bounds__(NWAVES * 64, 2) nsa_block_fwd(Args args) {
    extern __shared__ __attribute__((aligned(16))) unsigned char lds[];
    LAS unsigned char* L = (LAS unsigned char*)lds;
    volatile LAS unsigned* MISC = (volatile LAS unsigned*)(L + MISC_OFF);
    const int tid0 = threadIdx.x;
#define FRESH_TID() int tid = threadIdx.x; asm volatile("" : "+v"(tid)); const int lane = tid & 63; const int wave = __builtin_amdgcn_readfirstlane(tid >> 6); const int gtid = vcu * (NWAVES * 64) + tid; (void)lane; (void)wave; (void)gtid
    const int G = gridDim.x; const int bx = blockIdx.x; const int vcu = (G % 8 == 0) ? (bx % 8) * (G / 8) + bx / 8 : bx;
    unsigned char* ws = args.ws;
    gu32* ctl = (gu32*)(ws + WS_CTL);
    for (int u = tid0; u < (LDS_BYTES - LDSCTL_OFF) / 4; u += NWAVES * 64) ((LAS unsigned*)(L + LDSCTL_OFF))[u] = 0u;
    __syncthreads();
    LAS unsigned long long* PT = (LAS unsigned long long*)(L + LDSCTL_OFF + 512);
    if (tid0 == 0) {
#pragma unroll
        for (int i = 0; i < 21; ++i) PT[i] = (unsigned long long)(uintptr_t)args.in[i]; }
    __syncthreads();
#define LDP(i) ((const float*)ldptr(PT, (i)))
    Ptrs P; P.out = args.out; P.ws = args.ws;
    XcdBarrier bar; bar.bar = (unsigned*)(ctl + CW_BAR); bar.x = 0; bar.st = nullptr;
    if (N_LAUNCHES == 1) bar = xcd_barrier_post((unsigned*)(ctl + CW_BAR), MISC + 8);
    const int lo = args.ph_lo, hi = args.ph_hi;
#ifndef PHMASK
#define PHMASK 0xff
#endif
#define IN(k) (((PHMASK >> (k)) & 1) && lo <= (k) && (k) < hi)
#define SEAM(k) do { if (IN(k) && IN((k) + 1)) xcd_barrier(bar); } while (0)
    const int nthr = G * NWAVES * 64;

    if (IN(0)) { FRESH_TID(); P.x = LDP(0); P.pos = (const int*)LDP(1); P.n1g = LDP(2); P.win = LDP(3); P.wa = LDP(5); P.kpe = LDP(8); P.kw1 = LDP(9); P.vpe = LDP(11); P.vw1 = LDP(12); P.wb = LDP(14); P.wo = LDP(15); P.n2g = LDP(16); P.wff = LDP(17); P.wdn = LDP(20);
        for (int rep = 0; rep < NREP(0); ++rep) p0_prologue(P, L, vcu, G, wave, lane); SEAM(0); }
    if (IN(1)) {
        pg8::Gemm g{(const pg8::bf16_t*)(ws + WS_H1), (const pg8::bf16_t*)(ws + WS_WIN), T, NIN, DM}; pg8::StaticOrder S; S.init(T, NIN, G, bx);
        pg8::EpiIn E{ws, LDP(6), LDP(7)};
        RepOrder<NREP(1)> SR{S}; pg8::gemm_phase<pg8::EpiIn, RepOrder<NREP(1)>, true, true>(L + RING_OFF, g, SR, E);
        SEAM(1);
    }
    if (IN(2)) { FRESH_TID(); P.kng = LDP(7); P.kw2 = LDP(10); P.vw2 = LDP(13);
        for (int rep = 0; rep < NREP(2); ++rep)
        for (int u = vcu; u < 256; u += G) compress_unit(P, u, L, tid);
        SEAM(2);
    }
    if (IN(3)) {
        const att::AttnP AP{ws, LDP(4), LDP(7)};
#ifndef ATT_DRY
#define ATT_DRY 0
#endif
        if (ATT_DRY) for (int idx = vcu; idx < 1024; idx += G) {
            const int bgi = (idx & 255) >> 4, s = idx & 15, rnd = idx >> 8;
            const int c = (rnd == 0) ? s : (rnd == 1) ? 31 - s : (rnd == 2) ? 32 + s : 63 - s;
            att::attn_unit<ATT_DRY>(bgi >> 1, bgi & 1, c, AP, (char*)lds + RING_OFF);
        }
        for (int idx = vcu; idx < 1024; idx += G) {
            const int bgi = (idx & 255) >> 4, s = idx & 15, rnd = idx >> 8;
            const int c = (rnd == 0) ? s : (rnd == 1) ? 31 - s : (rnd == 2) ? 32 + s : 63 - s;
            att::attn_unit<0>(bgi >> 1, bgi & 1, c, AP, (char*)lds + RING_OFF);
        }
        SEAM(3);
    }
    if (IN(4)) {
#ifdef SELFCHECK
        { const int gt = vcu * (NWAVES * 64) + (int)threadIdx.x; const int sidx = (gt % 64) * 64 + gt / 64;
          if (gt < CHK_NS) selfcheck_sample(ws, sidx); }
        xcd_barrier(bar);
#endif
        pg8::Gemm g{(const pg8::bf16_t*)(ws + WS_YAB), (const pg8::bf16_t*)(ws + WS_WA), T, DM, DM}; pg8::StaticOrder S; S.init(T, DM, G, bx);
        pg8::EpiMerge E{(const pg8::bf16_t*)(ws + WS_GM), (pg8::bf16_t*)(ws + WS_MIX)};
        RepOrder<NREP(4)> SR{S}; pg8::gemm_phase<pg8::EpiMerge, RepOrder<NREP(4)>, true, true>(L + RING_OFF, g, SR, E);
        SEAM(4);
    }
    if (IN(5)) {
        pg8::Gemm g{(const pg8::bf16_t*)(ws + WS_MIX), (const pg8::bf16_t*)(ws + WS_WO), T, DM, DM}; pg8::StaticOrder S; S.init(T, DM, G, bx);
        pg8::EpiWO E{LDP(0), (pg8::bf16_t*)(ws + WS_X1B), (float*)(ws + WS_SSQ)};
        RepOrder<NREP(5)> SR{S}; pg8::gemm_phase<pg8::EpiWO, RepOrder<NREP(5)>, true, true>(L + RING_OFF, g, SR, E);
        SEAM(5);
    }
    if (IN(6)) { FRESH_TID(); P.fcw = LDP(18); P.fcb = LDP(19);
        pg8::Gemm g{(const pg8::bf16_t*)(ws + WS_X1B), (const pg8::bf16_t*)(ws + WS_WFF), T, NFF, DM}; pg8::StaticOrder S; S.init(T, NFF, G, bx);
        { pg8::Unit uu; float* RS = (float*)(ws + WS_RS); const float* SSQ = (const float*)(ws + WS_SSQ);
          int lastpm = -1;
          for (int i = 0; S.next(i, uu); ++i) if (uu.pm != lastpm) { lastpm = uu.pm; if (tid < 256) { const size_t row = (size_t)uu.pm * 256 + tid; float s = 0.f;
#pragma unroll
              for (int j = 0; j < 16; ++j) s += SSQ[row * 16 + j];
              RS[row] = -1.4426950408889634f / sqrtf(s * (1.0f / 1024.0f) + 1e-6f); } }
          VM_WAIT(); __syncthreads(); }
        pg8::EpiFF1 E{(const float*)(ws + WS_RS), (pg8::bf16_t*)(ws + WS_ACT), (float*)(ws + WS_TAIL), (float*)(ws + WS_HEADP), (float*)(ws + WS_HEADU), P.fcw, P.fcb, (LAS float*)(L + LDSCTL_OFF + 1024)};
        RepOrder<NREP(6)> SR{S}; pg8::gemm_phase<pg8::EpiFF1, RepOrder<NREP(6)>, true, true>(L + RING_OFF, g, SR, E);
        SEAM(6);
    }
    if (IN(7)) { FRESH_TID(); P.fcw = LDP(18);
        { pg8::StaticOrder S0; S0.init(T, DM, G, bx); pg8::Unit uu; for (int i = 0; S0.next(i, uu); ++i) ffn_fix_rows(ws, P.fcw, uu.pm, tid); VM_WAIT(); __syncthreads(); }
        pg8::Gemm g{(const pg8::bf16_t*)(ws + WS_ACT), (const pg8::bf16_t*)(ws + WS_WDN), T, DM, DFF}; pg8::StaticOrder S; S.init(T, DM, G, bx);
        pg8::EpiFF2 E{(const pg8::bf16_t*)(ws + WS_X1B), P.out};
        static_assert(T / 256 * (DM / 256) == 2 * 256, "two rounds on 256 CUs");
        if (G == 256) { RevOrder<2> SR{S}; pg8::gemm_phase<pg8::EpiFF2, RevOrder<2>, true, true>(L + RING_OFF, g, SR, E); }
        else { RepOrder<NREP(7)> SR{S}; pg8::gemm_phase<pg8::EpiFF2, RepOrder<NREP(7)>, true, true>(L + RING_OFF, g, SR, E); }
    }
#ifdef SELFCHECK
    if (IN(7)) { xcd_barrier(bar); const unsigned* cc = (const unsigned*)(ws + WS_CTL) + CW_CHK; const unsigned nd = __hip_atomic_load(cc, RLX_AGENT), nm = __hip_atomic_load(cc + 1, RLX_AGENT), no = __hip_atomic_load(cc + 2, RLX_AGENT);
        const bool bad = (nd != (unsigned)CHK_NS) || (nm > CHK_MAXMASK) || (no > CHK_MAXOUT);
        if (bad && blockIdx.x == 0) { for (int i = threadIdx.x; i < 4096; i += NWAVES * 64) P.out[i] = __builtin_nanf(""); } }
#endif
#undef IN
#undef SEAM
}

extern "C" void kernel_launch(void* const* d_in, const int* in_sizes, int n_in, void* d_out, int out_size, void* d_ws, size_t ws_size, hipStream_t stream) {
    static int grid = 0;
    if (grid == 0) {
        if (n_in != 21 || in_sizes[0] != T * DM || out_size != T * DM || ws_size < WS_END) {
            fprintf(stderr, "kernel_launch: unexpected problem: n_in %d in0 %d out %d ws %zu (need >= %zu)\n", n_in, n_in > 0 ? in_sizes[0] : -1, out_size, ws_size, (size_t)WS_END); grid = -1; return; }
        int dev = 0, cus = 0, per_cu = 0;
        if (hipGetDevice(&dev) != hipSuccess || hipDeviceGetAttribute(&cus, hipDeviceAttributeMultiprocessorCount, dev) != hipSuccess) { fprintf(stderr, "kernel_launch: device query failed\n"); grid = -1; return; }
        if (hipFuncSetAttribute((const void*)nsa_block_fwd, hipFuncAttributeMaxDynamicSharedMemorySize, LDS_BYTES) != hipSuccess) { fprintf(stderr, "kernel_launch: hipFuncSetAttribute failed\n"); grid = -1; return; }
        if (hipOccupancyMaxActiveBlocksPerMultiprocessor(&per_cu, (const void*)nsa_block_fwd, NWAVES * 64, LDS_BYTES) != hipSuccess || per_cu < 1)
            fprintf(stderr, "kernel_launch: occupancy query reports %d workgroups per CU\n", per_cu);
        (void)hipGetLastError();
        grid = cus;
    }
    if (grid < 0) return;
    if (hipMemsetAsync((char*)d_ws + WS_CTL, 0, CTL_ZERO_BYTES, stream) != hipSuccess) { fprintf(stderr, "kernel_launch: memset failed\n"); return; }
    Args a{};
    for (int i = 0; i < 21; ++i) a.in[i] = d_in[i];
    a.out = (float*)d_out; a.ws = (unsigned char*)d_ws;
    for (int li = 0; li < N_LAUNCHES; ++li) {
        a.ph_lo = (N_LAUNCHES == 1) ? 0 : li; a.ph_hi = (N_LAUNCHES == 1) ? N_PHASES : li + 1; a.li = li;
        hipLaunchKernelGGL(nsa_block_fwd, dim3(grid), dim3(NWAVES * 64), LDS_BYTES, stream, a);
        const hipError_t le = hipPeekAtLastError();
        if (le != hipSuccess) { fprintf(stderr, "kernel_launch: launch %d failed: %s\n", li, hipGetErrorName(le)); break; }
    }
}
```

```cpp
#include <hip/hip_runtime.h>
#include <hip/hip_bf16.h>
#include <cstdio>
#include <cstdint>
#include <cmath>
constexpr int NBATCH = 8, SEQ = 4096, T = NBATCH * SEQ, DM = 1024, INCOLS = 4888, NIN = 5120, DFF = 2816, NFF = 2 * DFF, CW = 512;
constexpr size_t MiB = 1u << 20;
constexpr size_t WS_CTL = 0, CTL_ZERO_BYTES = 1 * MiB;
constexpr size_t WS_CB = 1 * MiB;
constexpr size_t WS_CMPK = 1 * MiB + 65536, WS_CMPV = WS_CMPK + 524288;
constexpr size_t WS_SSQ = 3 * MiB;
constexpr size_t WS_GNSA = 5 * MiB;
constexpr size_t WS_WIN = 8 * MiB, WS_WA = 18 * MiB, WS_WB = 19 * MiB, WS_WO = 20 * MiB, WS_WFF = 22 * MiB, WS_WDN = 33 * MiB, WS_W1K = 39 * MiB, WS_W1V = 39 * MiB + 262144;
constexpr size_t WS_CS = 40 * MiB;
constexpr size_t WS_TAIL = 48 * MiB, WS_HEADP = 51 * MiB, WS_HEADU = 54 * MiB;
constexpr size_t WS_RS = 57 * MiB;
constexpr size_t WS_X1B = 64 * MiB;
constexpr size_t WS_H1 = 160 * MiB, WS_YAB = 160 * MiB;
constexpr size_t WS_AB = 224 * MiB, WS_ACX = 256 * MiB;
constexpr size_t WS_Q = 288 * MiB, WS_KC = 320 * MiB, WS_VC = 328 * MiB, WS_KS = 336 * MiB, WS_VS = 344 * MiB, WS_KW = 352 * MiB, WS_VW = 360 * MiB, WS_MIX = 288 * MiB;
constexpr size_t WS_GM = 370 * MiB;
constexpr size_t WS_ACT = 160 * MiB, WS_END = 512 * MiB;
constexpr int CW_BAR = 4096;
namespace pg8 {
#define PG8_LAS __attribute__((address_space(3)))
typedef unsigned short bf16_t;
typedef short bf16x8 __attribute__((ext_vector_type(8)));
typedef float f32x4 __attribute__((ext_vector_type(4)));
typedef unsigned u32x4 __attribute__((ext_vector_type(4)));
constexpr int BM = 256, BK = 64, HALF = 128, HTB = HALF * BK * 2  , STAGE_BYTES = 8 * HTB, NXCD = 8, WGM = 4;

__host__ __device__ __forceinline__ int lds_byte(int r, int c) { const int st = (r >> 4) * 2 + (c >> 5), rr = r & 15, cc = c & 31, ob = rr * 64 + cc * 2; return st * 1024 + (ob ^ (((ob >> 9) & 1) << 5)); }
__host__ __device__ __forceinline__ void stage_rc(int b, int& R, int& C) { const int st = b / 1024, sb = b % 1024, swz = sb ^ (((sb >> 9) & 1) << 5); R = (st >> 1) * 16 + swz / 64; C = (st & 1) * 32 + (swz % 64) / 2; }
__host__ __device__ __forceinline__ int perm32(int rho) { const int n = rho >> 4, i = rho & 15; return 8 * (i >> 2) + 4 * n + (i & 3); }

struct Unit { int pm, pn; };
struct Gemm { const bf16_t* A; const bf16_t* Bt; int M, N, K; };

struct StaticOrder {
    int nM, nN, nwg, G, c;
    __host__ __device__ void init(int M, int N, int G_, int c_) { nM = M / BM; nN = N / BM; nwg = nM * nN; G = G_; c = c_; }
    __host__ __device__ bool next(int i, Unit& u) const {
        const long L = (long)i * G + c; if (L >= nwg) return false;
        int wgid = (int)L; { const int q = nwg / NXCD, r = nwg % NXCD, xcd = wgid % NXCD, off = wgid / NXCD; wgid = (xcd < r ? xcd * (q + 1) : r * (q + 1) + (xcd - r) * q) + off; }
        const int nig = WGM * nN, gid = wgid / nig, fm = gid * WGM, gsz = (nM - fm) < WGM ? (nM - fm) : WGM;
        u.pm = fm + ((wgid % nig) % gsz); u.pn = (wgid % nig) / gsz; return true;
    }
    __device__ __forceinline__ void a_ready(const Unit&) const {}
    __device__ __forceinline__ void done(const Unit&) const {}
};

typedef float f32x2_cv __attribute__((ext_vector_type(2))); typedef __bf16 bf16x2_cv __attribute__((ext_vector_type(2)));
__device__ __forceinline__ unsigned cvt_pk_bf16(float lo, float hi) { f32x2_cv v = {lo, hi}; bf16x2_cv b = __builtin_convertvector(v, bf16x2_cv); return __builtin_bit_cast(unsigned, b); }
typedef float f32x2 __attribute__((ext_vector_type(2)));
constexpr float EPSN = 1e-6f;
constexpr float QC2 = 0.125f * 1.4426950408889634f;
__device__ __forceinline__ u32x4 pack8(const f32x4 a, const f32x4 b) { u32x4 w; w.x = cvt_pk_bf16(a[0], a[1]); w.y = cvt_pk_bf16(a[2], a[3]); w.z = cvt_pk_bf16(b[0], b[1]); w.w = cvt_pk_bf16(b[2], b[3]); return w; }
__device__ __forceinline__ void unpack8(const u32x4 w, f32x4& a, f32x4& b) {
    a[0] = __uint_as_float(w.x << 16); a[1] = __uint_as_float(w.x & 0xffff0000u); a[2] = __uint_as_float(w.y << 16); a[3] = __uint_as_float(w.y & 0xffff0000u);
    b[0] = __uint_as_float(w.z << 16); b[1] = __uint_as_float(w.z & 0xffff0000u); b[2] = __uint_as_float(w.w << 16); b[3] = __uint_as_float(w.w & 0xffff0000u); }
__device__ __forceinline__ float sigm(float x) { return __builtin_amdgcn_rcpf(1.0f + __builtin_amdgcn_exp2f(-1.4426950408889634f * x)); }
__device__ __forceinline__ f32x4 sigm4(const f32x4 v) { return (f32x4){sigm(v[0]), sigm(v[1]), sigm(v[2]), sigm(v[3])}; }
__device__ __forceinline__ float dot4(const f32x4 v) { return (v[0] * v[0] + v[1] * v[1]) + (v[2] * v[2] + v[3] * v[3]); }

struct EpiIn {
    static constexpr bool PERM = true, AFTER_DRAIN = false, PREFETCH = false; static constexpr int MID_T = -1;
    unsigned char* ws; const float* qg; const float* kg;
    __device__ __forceinline__ void operator()(const f32x4 (&acc)[2][2][4][2], const Unit& u, int wr, int wc, int fr, int fq) const {
        const int pn = u.pn; const int row0 = u.pm * BM + wr * 64 + fr;
        bf16_t* const AB = (bf16_t*)(ws + WS_AB); bf16_t* const ACX = (bf16_t*)(ws + WS_ACX); bf16_t* const Q = (bf16_t*)(ws + WS_Q);
        float* const GNSA = (float*)(ws + WS_GNSA); const float* const CS = (const float*)(ws + WS_CS);
        if (pn < 2) {
#pragma unroll
            for (int ai = 0; ai < 2; ++ai)
#pragma unroll
                for (int m = 0; m < 4; ++m) { const size_t row = (size_t)(row0 + ai * HALF + m * 16);
#pragma unroll
                    for (int bj = 0; bj < 2; ++bj) __builtin_nontemporal_store(pack8(acc[ai][bj][m][0], acc[ai][bj][m][1]), (u32x4*)(AB + row * 512 + pn * 256 + bj * HALF + wc * 32 + fq * 8)); }
        } else if (pn < 6) {
            const int ch = (pn - 2) * 128 + wc * 32 + fq * 8;
#pragma unroll
            for (int ai = 0; ai < 2; ++ai)
#pragma unroll
                for (int m = 0; m < 4; ++m) { const size_t row = (size_t)(row0 + ai * HALF + m * 16);
                    __builtin_nontemporal_store(pack8(acc[ai][0][m][0] * acc[ai][1][m][0], acc[ai][0][m][1] * acc[ai][1][m][1]), (u32x4*)(ACX + row * 512 + ch)); }
        } else if (pn < 9) {
            const bool isq = pn < 8;
            const float* gam = isq ? qg : (kg + (wc < 2 ? 64 : 128));
            const f32x4 g00 = *(const f32x4*)(gam + 8 * fq), g01 = *(const f32x4*)(gam + 8 * fq + 4), g10 = *(const f32x4*)(gam + 32 + 8 * fq), g11 = *(const f32x4*)(gam + 32 + 8 * fq + 4);
            const float osc = isq ? QC2 : 1.0f;
#pragma unroll
            for (int ai = 0; ai < 2; ++ai)
#pragma unroll
                for (int m = 0; m < 4; ++m) { const int row = row0 + ai * HALF + m * 16;
                    const f32x4 v00 = acc[ai][0][m][0], v01 = acc[ai][0][m][1], v10 = acc[ai][1][m][0], v11 = acc[ai][1][m][1];
                    float ss = (dot4(v00) + dot4(v01)) + (dot4(v10) + dot4(v11));
                    ss += __shfl_xor(ss, 16); ss += __shfl_xor(ss, 32);
                    const float r = 1.0f / sqrtf(ss * (1.0f / 64.0f) + EPSN);
                    const f32x4 x1a = v00 * r * g00, x1b = v01 * r * g01, x2a = v10 * r * g10, x2b = v11 * r * g11;
                    const float* cs = CS + (size_t)row * 64 + 8 * fq;
                    const f32x4 ca = *(const f32x4*)(cs), cb = *(const f32x4*)(cs + 4), sa = *(const f32x4*)(cs + 32), sb = *(const f32x4*)(cs + 36);
                    const f32x4 o1a = (x1a * ca - x2a * sa) * osc, o1b = (x1b * cb - x2b * sb) * osc, o2a = (x2a * ca + x1a * sa) * osc, o2b = (x2b * cb + x1b * sb) * osc;
                    bf16_t* dst;
                    if (isq) dst = Q + (size_t)row * 512 + (4 * (pn - 6) + wc) * 64;
                    else dst = (bf16_t*)(ws + (wc < 2 ? WS_KS : WS_KW)) + ((size_t)((row >> 12) * 2 + (wc & 1)) * 4096 + (row & 4095)) * 64;
                    *(u32x4*)(dst + 8 * fq) = pack8(o1a, o1b); *(u32x4*)(dst + 32 + 8 * fq) = pack8(o2a, o2b); }
        } else if (pn < 11) {
            bf16_t* base = (bf16_t*)(ws + ((pn == 9) ? (wc < 2 ? WS_KC : WS_VC) : (wc < 2 ? WS_VS : WS_VW)));
#pragma unroll
            for (int ai = 0; ai < 2; ++ai)
#pragma unroll
                for (int m = 0; m < 4; ++m) { const int row = row0 + ai * HALF + m * 16;
                    bf16_t* dst = base + ((size_t)((row >> 12) * 2 + (wc & 1)) * 4096 + (row & 4095)) * 64;
                    *(u32x4*)(dst + 8 * fq) = pack8(acc[ai][0][m][0], acc[ai][0][m][1]); *(u32x4*)(dst + 32 + 8 * fq) = pack8(acc[ai][1][m][0], acc[ai][1][m][1]); }
        } else if (pn == 11) {
            if (wc == 0 && fq < 3) {
#pragma unroll
                for (int ai = 0; ai < 2; ++ai)
#pragma unroll
                    for (int m = 0; m < 4; ++m) { const size_t row = (size_t)(row0 + ai * HALF + m * 16);
                        *(f32x4*)(GNSA + row * 24 + 8 * fq) = sigm4(acc[ai][0][m][0]); *(f32x4*)(GNSA + row * 24 + 8 * fq + 4) = sigm4(acc[ai][0][m][1]); } }
        } else {
            bf16_t* const GM = (bf16_t*)(ws + WS_GM);
#pragma unroll
            for (int ai = 0; ai < 2; ++ai)
#pragma unroll
                for (int m = 0; m < 4; ++m) { const size_t row = (size_t)(row0 + ai * HALF + m * 16);
#pragma unroll
                    for (int bj = 0; bj < 2; ++bj) __builtin_nontemporal_store(pack8(sigm4(acc[ai][bj][m][0]), sigm4(acc[ai][bj][m][1])), (u32x4*)(GM + row * 2048 + (pn - 12) * 256 + bj * HALF + wc * 32 + fq * 8)); }
        }
    }
};
template <bool ADD> struct EpiGate {
    static constexpr bool PERM = true, AFTER_DRAIN = false, PREFETCH = false; static constexpr int MID_T = -1;
    const bf16_t* GM; int goff; const bf16_t* ADDSRC; bf16_t* O;
    __device__ __forceinline__ void operator()(const f32x4 (&acc)[2][2][4][2], const Unit& u, int wr, int wc, int fr, int fq) const {
        const int row0 = u.pm * BM + wr * 64 + fr;
#pragma unroll
        for (int ai = 0; ai < 2; ++ai)
#pragma unroll
            for (int m = 0; m < 4; ++m) { const size_t row = (size_t)(row0 + ai * HALF + m * 16);
#pragma unroll
                for (int bj = 0; bj < 2; ++bj) { const int col = u.pn * BM + bj * HALF + wc * 32 + fq * 8;
                    f32x4 ga, gb; unpack8(*(const u32x4*)(GM + row * 2048 + goff + col), ga, gb);
                    f32x4 ra = ga * acc[ai][bj][m][0], rb = gb * acc[ai][bj][m][1];
                    if (ADD) { f32x4 aa, ab; unpack8(*(const u32x4*)(ADDSRC + row * 1024 + col), aa, ab); ra += aa; rb += ab; }
                    *(u32x4*)(O + row * 1024 + col) = pack8(ra, rb); } }
    }
};
struct EpiMerge {
    static constexpr bool PERM = true, AFTER_DRAIN = false, PREFETCH = false; static constexpr int MID_T = 8;
    const bf16_t* GM; bf16_t* O;
    __device__ __forceinline__ void mid(f32x4 (&acc)[2][2][4][2], const Unit& u, int wr, int wc, int fr_in, int fq_in) const {
        int fr = fr_in, fq = fq_in; asm volatile("" : "+v"(fr), "+v"(fq));
        const bf16_t* gbase = GM + (size_t)u.pm * BM * 2048 + u.pn * BM;
#pragma unroll
        for (int ai = 0; ai < 2; ++ai)
#pragma unroll
            for (int m = 0; m < 4; ++m)
#pragma unroll
                for (int bj = 0; bj < 2; ++bj) { const unsigned off = (unsigned)((wr * 64 + ai * HALF + m * 16 + fr) * 2048 + bj * HALF + wc * 32 + fq * 8);
                    f32x4 a0, a1, b0, b1; unpack8(*(const u32x4*)(gbase + off), a0, a1); unpack8(*(const u32x4*)(gbase + off + 1024), b0, b1);
#pragma unroll
                    for (int i = 0; i < 4; ++i) { acc[ai][bj][m][0][i] *= b0[i] * __builtin_amdgcn_rcpf(fmaxf(a0[i], 1e-30f)); acc[ai][bj][m][1][i] *= b1[i] * __builtin_amdgcn_rcpf(fmaxf(a1[i], 1e-30f)); } }
    }
    __device__ __forceinline__ void operator()(const f32x4 (&acc)[2][2][4][2], const Unit& u, int wr, int wc, int fr_in, int fq_in) const {
        int fr = fr_in, fq = fq_in; asm volatile("" : "+v"(fr), "+v"(fq));
        const bf16_t* gbase = GM + (size_t)u.pm * BM * 2048 + u.pn * BM; bf16_t* obase = O + (size_t)u.pm * BM * 1024 + u.pn * BM;
#pragma unroll
        for (int ai = 0; ai < 2; ++ai)
#pragma unroll
            for (int m = 0; m < 4; ++m)
#pragma unroll
                for (int bj = 0; bj < 2; ++bj) { const unsigned rl = (unsigned)(wr * 64 + ai * HALF + m * 16 + fr), cl = (unsigned)(bj * HALF + wc * 32 + fq * 8);
                    f32x4 a0, a1; unpack8(*(const u32x4*)(gbase + rl * 2048 + cl), a0, a1);
                    __builtin_nontemporal_store(pack8(acc[ai][bj][m][0] * a0, acc[ai][bj][m][1] * a1), (u32x4*)(obase + rl * 1024 + cl)); }
    }
};
struct EpiWO {
    static constexpr bool PERM = true, AFTER_DRAIN = false, PREFETCH = false; static constexpr int MID_T = -1;
    const float* X; bf16_t* X1B; float* SSQ;
    __device__ __forceinline__ void operator()(const f32x4 (&acc)[2][2][4][2], const Unit& u, int wr, int wc, int fr, int fq) const {
        const int row0 = u.pm * BM + wr * 64 + fr;
#pragma unroll
        for (int ai = 0; ai < 2; ++ai)
#pragma unroll
            for (int m = 0; m < 4; ++m) { const size_t row = (size_t)(row0 + ai * HALF + m * 16); float ss = 0.f;
#pragma unroll
                for (int bj = 0; bj < 2; ++bj) { const int col = u.pn * BM + bj * HALF + wc * 32 + fq * 8;
                    const f32x4 ya = *(const f32x4*)(X + row * 1024 + col) + acc[ai][bj][m][0], yb = *(const f32x4*)(X + row * 1024 + col + 4) + acc[ai][bj][m][1];
                    *(u32x4*)(X1B + row * 1024 + col) = pack8(ya, yb); ss += dot4(ya) + dot4(yb); }
                ss += __shfl_xor(ss, 16); ss += __shfl_xor(ss, 32);
                if (fq == 0) SSQ[row * 16 + u.pn * 4 + wc] = ss; }
    }
};
__device__ __forceinline__ f32x4 dpp_ror1(const f32x4 v) { f32x4 r;
#pragma unroll
    for (int i = 0; i < 4; ++i) r[i] = __int_as_float(__builtin_amdgcn_mov_dpp(__float_as_int(v[i]), 0x121, 0xF, 0xF, false)); return r; }
__device__ __forceinline__ f32x4 dpp_ror2(const f32x4 v) { f32x4 r;
#pragma unroll
    for (int i = 0; i < 4; ++i) r[i] = __int_as_float(__builtin_amdgcn_mov_dpp(__float_as_int(v[i]), 0x122, 0xF, 0xF, false)); return r; }
__device__ __forceinline__ f32x4 silu4(const f32x4 v) { return (f32x4){v[0] * sigm(v[0]), v[1] * sigm(v[1]), v[2] * sigm(v[2]), v[3] * sigm(v[3])}; }
struct EpiFF1 {
    static constexpr bool PERM = true, AFTER_DRAIN = false, PREFETCH = true; static constexpr int MID_T = -1;
    const float* RS; bf16_t* ACT; float* TAIL; float* HEADP; float* HEADU; const float* cw; const float* cb; PG8_LAS float* hl;
    __device__ __forceinline__ void pre(const Unit& u, int par, int wid, int lane_in) const {
        int lane = lane_in; asm volatile("" : "+v"(lane));
        if (wid < 4) __builtin_amdgcn_global_load_lds((const unsigned*)(RS + (size_t)u.pm * BM + wid * 64 + lane), (PG8_LAS unsigned*)(hl + 1024 + par * 256 + wid * 64), 4, 0, 0);
        const int arr = wid >> 1; const float* src = (arr < 3 ? cw + arr * 2816 : cb) + u.pn * 128 + (wid & 1) * 64 + lane;
        __builtin_amdgcn_global_load_lds((const unsigned*)src, (PG8_LAS unsigned*)(hl + 1536 + par * 512 + wid * 64), 4, 0, 0);
    }
    __device__ __forceinline__ void ep(const f32x4 (&acc)[2][2][4][2], const Unit& u, int wr, int wc, int fr_in, int fq_in, int par) const {
        int fr = fr_in, fq = fq_in; asm volatile("" : "+v"(fr), "+v"(fq));
        const int pm = __builtin_amdgcn_readfirstlane(u.pm), pn = __builtin_amdgcn_readfirstlane(u.pn);
        const int chl = wc * 32 + fq * 8, ch = pn * 128 + chl;
        const PG8_LAS float* rl = hl + 1024 + par * 256 + wr * 64 + fr;
        const PG8_LAS float* cl = hl + 1536 + par * 512 + chl;
        if (fr >= 14) {
#pragma unroll
            for (int ai = 0; ai < 2; ++ai) { PG8_LAS float* h = hl + ((ai * 2 + wr) * 2 + (fr - 14)) * 128 + chl; const float r3 = rl[ai * HALF + 48];
                const f32x4 ga = acc[ai][0][3][0] * r3, gb = acc[ai][0][3][1] * r3;
                *(PG8_LAS f32x4*)h = ga; *(PG8_LAS f32x4*)(h + 4) = gb;
                if (ai == 1 && wr == 1) { float* tp = TAIL + ((size_t)pm * 2 + (fr - 14)) * 2816 + ch; *(f32x4*)tp = ga; *(f32x4*)(tp + 4) = gb; } } }
        asm volatile("s_waitcnt lgkmcnt(0)\n\ts_barrier" ::: "memory");
        char* tile_act; { const unsigned long long v = (unsigned long long)(ACT + (size_t)pm * BM * 2816 + pn * 128);
            tile_act = (char*)(((unsigned long long)(unsigned)__builtin_amdgcn_readfirstlane((int)(v >> 32)) << 32) | (unsigned)__builtin_amdgcn_readfirstlane((int)(unsigned)v)); }
        char* tile_hp = (char*)(HEADP + (size_t)pm * 2 * 2816 + pn * 128); char* tile_hu = (char*)(HEADU + (size_t)pm * 2 * 2816 + pn * 128);
        const unsigned vbase = (unsigned)((wr * 64 + fr) * 2816 + chl) * 2u;
#pragma unroll
        for (int ai = 0; ai < 2; ++ai) {
            const int blk = ai * 2 + wr;
            f32x4 c1[2], c2[2];
#pragma unroll
            for (int n = 0; n < 2; ++n) { f32x4 h0 = (f32x4){0.f, 0.f, 0.f, 0.f}, h1 = h0;
                if (blk > 0) { h0 = *(const PG8_LAS f32x4*)(hl + ((blk - 1) * 2 + 0) * 128 + chl + 4 * n); h1 = *(const PG8_LAS f32x4*)(hl + ((blk - 1) * 2 + 1) * 128 + chl + 4 * n); }
                c1[n] = h1; c2[n] = (fr == 0) ? h0 : h1; }
#pragma unroll
            for (int m = 0; m < 4; ++m) {
                const unsigned voff = vbase + (unsigned)((ai * HALF + m * 16) * 2816 * 2);
                const float rsv = rl[ai * HALF + m * 16], rsu = rsv * 0.4804530139182014f;
                f32x4 o;
#pragma unroll
                for (int n = 0; n < 2; ++n) {
                    const f32x4 w0 = *(const PG8_LAS f32x4*)(cl + 4 * n), w1 = *(const PG8_LAS f32x4*)(cl + 128 + 4 * n), w2 = *(const PG8_LAS f32x4*)(cl + 256 + 4 * n), bb = *(const PG8_LAS f32x4*)(cl + 384 + 4 * n) * -1.4426950408889634f;
                    const f32x4 cur = acc[ai][0][m][n] * rsv;
                    const f32x4 r1 = dpp_ror1(cur), r2 = dpp_ror2(cur);
                    f32x4 p1 = r1, p2 = r2;
                    if (fr == 0) p1 = c1[n];
                    if (fr < 2) p2 = c2[n];
                    c1[n] = r1; c2[n] = r2;
                    const f32x4 pre = (w0 * p2 + w1 * p1) + (w2 * cur + bb);
                    const f32x4 uv = acc[ai][1][m][n] * rsu;
                    f32x4 sg;
#pragma unroll
                    for (int i = 0; i < 4; ++i) sg[i] = __builtin_amdgcn_rcpf(1.0f + __builtin_amdgcn_exp2f(pre[i]));
                    const f32x4 res = (pre * sg) * uv;
                    o[2 * n] = __uint_as_float(cvt_pk_bf16(res[0], res[1])); o[2 * n + 1] = __uint_as_float(cvt_pk_bf16(res[2], res[3]));
                    if (blk == 0 && m == 0 && fr < 2) { const unsigned hoff = (unsigned)(fr * 2816 + chl + 4 * n) * 4u; *(f32x4*)(tile_hp + hoff) = pre; *(f32x4*)(tile_hu + hoff) = uv; } }
                asm volatile("global_store_dwordx4 %0, %1, %2 nt" :: "v"(voff), "v"(o), "s"(tile_act) : "memory");
                __builtin_amdgcn_sched_barrier(0); }
        }
    }
};
struct EpiFF2 {
    static constexpr bool PERM = true, AFTER_DRAIN = false, PREFETCH = false; static constexpr int MID_T = -1;
    const bf16_t* X1B; float* OUT;
    __device__ __forceinline__ void operator()(const f32x4 (&acc)[2][2][4][2], const Unit& u, int wr, int wc, int fr, int fq) const {
        const int row0 = u.pm * BM + wr * 64 + fr;
#pragma unroll
        for (int ai = 0; ai < 2; ++ai)
#pragma unroll
            for (int m = 0; m < 4; ++m) { const size_t row = (size_t)(row0 + ai * HALF + m * 16);
#pragma unroll
                for (int bj = 0; bj < 2; ++bj) { const size_t off = row * 1024 + u.pn * BM + bj * HALF + wc * 32 + fq * 8;
                    f32x4 xa, xb; unpack8(*(const u32x4*)(X1B + off), xa, xb);
                    __builtin_nontemporal_store(xa + acc[ai][bj][m][0], (f32x4*)(OUT + off)); __builtin_nontemporal_store(xb + acc[ai][bj][m][1], (f32x4*)(OUT + off + 4)); } }
    }
};
template <class Epi, class Sched, bool ALIGN_EPI = false, bool SP2 = false>
__device__ __forceinline__ void gemm_phase(PG8_LAS unsigned char* lds, const Gemm g, const Sched& S, const Epi& E) {
    const int tid = threadIdx.x, wid = __builtin_amdgcn_readfirstlane(tid >> 6), lane = tid & 63, wr = wid >> 2, wc = wid & 3, fr = lane & 15, fq = lane >> 4;
    const int K = g.K, nt = K / BK;
    unsigned voffA[2], voffB[2];
#pragma unroll
    for (int i = 0; i < 2; ++i) { int R, C; stage_rc(tid * 16 + i * 8192, R, C); const int Rb = Epi::PERM ? ((R & ~31) + perm32(R & 31)) : R;
        voffA[i] = (unsigned)(R * K + C) * 2u; voffB[i] = (unsigned)(Rb * K + C) * 2u; }
    const size_t kstep = (size_t)(BK * 2);
    const size_t hstep = (size_t)HALF * K * 2;
    const size_t tstep = 2 * hstep;
    const unsigned ldsw = (unsigned)wid * 1024u;
    const int aoff = lds_byte(wr * 64 + fr, fq * 8), boff = lds_byte(wc * 32 + fr, fq * 8);
#define PG8_SA(b, h) (((b) * 2 + (h)) * HTB)
#define PG8_SB(b, h) ((4 + (b) * 2 + (h)) * HTB)
#define PG8_STAGE(bufoff, gbase, voff) do { _Pragma("unroll") for (int _i = 0; _i < 2; ++_i) \
        __builtin_amdgcn_global_load_lds((const unsigned*)((const char*)(gbase) + (voff)[_i]), (PG8_LAS unsigned*)(lds + (bufoff) + ldsw + _i * 8192), 16, 0, 0); } while (0)
#define PG8_LDA(dst, b, h) do { _Pragma("unroll") for (int m = 0; m < 4; ++m) _Pragma("unroll") for (int k = 0; k < 2; ++k) dst[m][k] = *(const PG8_LAS bf16x8*)(lds + PG8_SA(b, h) + aoff + m * 2048 + k * 1024); } while (0)
#define PG8_LDB(dst, b, h) do { _Pragma("unroll") for (int n = 0; n < 2; ++n) _Pragma("unroll") for (int k = 0; k < 2; ++k) dst[n][k] = *(const PG8_LAS bf16x8*)(lds + PG8_SB(b, h) + boff + n * 2048 + k * 1024); } while (0)
#define PG8_MMA(ai, bj, At, Bt) do { __builtin_amdgcn_s_setprio(1); _Pragma("unroll") for (int m = 0; m < 4; ++m) _Pragma("unroll") for (int n = 0; n < 2; ++n) _Pragma("unroll") for (int k = 0; k < 2; ++k) \
        acc[ai][bj][m][n] = __builtin_amdgcn_mfma_f32_16x16x32_bf16(Bt[n][k], At[m][k], acc[ai][bj][m][n], 0, 0, 0); __builtin_amdgcn_s_setprio(0); } while (0)
#define PG8_WAIT_V(n) asm volatile("s_waitcnt vmcnt(" #n ")" ::: "memory")
#define PG8_WAIT_L(n) asm volatile("s_waitcnt lgkmcnt(" #n ")" ::: "memory")
#define PG8_BAR __builtin_amdgcn_s_barrier()
#define PG8_SCHED __builtin_amdgcn_sched_barrier(0)
    Unit cur, nxt; int ui = 0;
    if (!S.next(0, cur)) return;
    f32x4 acc[2][2][4][2];
#pragma unroll
    for (int a = 0; a < 2; ++a)
#pragma unroll
        for (int b = 0; b < 2; ++b)
#pragma unroll
            for (int m = 0; m < 4; ++m)
#pragma unroll
                for (int n = 0; n < 2; ++n) acc[a][b][m][n] = (f32x4){0.f, 0.f, 0.f, 0.f};
    bf16x8 At[4][2], B0[2][2], B1[2][2];
    const char* cA = (const char*)g.A + (size_t)cur.pm * tstep; const char* cB = (const char*)g.Bt + (size_t)cur.pn * tstep;
    S.a_ready(cur);
    if constexpr (Epi::PREFETCH) E.pre(cur, 0, wid, lane);
    if constexpr (SP2) {
        PG8_STAGE(PG8_SB(0, 0), cB, voffB); PG8_STAGE(PG8_SB(0, 1), cB + hstep, voffB); PG8_STAGE(PG8_SA(0, 0), cA, voffA); PG8_STAGE(PG8_SA(0, 1), cA + hstep, voffA);
        if (wr == 1) PG8_BAR;
        PG8_WAIT_V(2); PG8_BAR;
        PG8_STAGE(PG8_SB(1, 0), cB + kstep, voffB); PG8_STAGE(PG8_SA(1, 0), cA + kstep, voffA); PG8_STAGE(PG8_SB(1, 1), cB + hstep + kstep, voffB);
        PG8_WAIT_V(6); PG8_BAR;
    } else {
        PG8_STAGE(PG8_SB(0, 0), cB, voffB); PG8_STAGE(PG8_SA(0, 0), cA, voffA); PG8_STAGE(PG8_SB(0, 1), cB + hstep, voffB); PG8_STAGE(PG8_SA(0, 1), cA + hstep, voffA);
        if (wr == 1) PG8_BAR;
        PG8_WAIT_V(4); PG8_BAR;
        PG8_STAGE(PG8_SB(1, 0), cB + kstep, voffB); PG8_STAGE(PG8_SA(1, 0), cA + kstep, voffA); PG8_STAGE(PG8_SB(1, 1), cB + hstep + kstep, voffB);
        PG8_WAIT_V(6); PG8_BAR;
    }
    for (;;) {
        const bool has_next = S.next(ui + 1, nxt);
        const char* nA = has_next ? (const char*)g.A + (size_t)nxt.pm * tstep : cA; const char* nB = has_next ? (const char*)g.Bt + (size_t)nxt.pn * tstep : cB;
        for (int t = 0; t < nt; t += 2) {
            if constexpr (Epi::MID_T >= 0) { if (t == Epi::MID_T) E.mid(acc, cur, wr, wc, fr, fq); }
            const bool last = (t == nt - 2);
            const char* a1 = cA + (size_t)(t + 1) * kstep;
            const char* a2 = last ? nA : cA + (size_t)(t + 2) * kstep; const char* b2 = last ? nB : cB + (size_t)(t + 2) * kstep;
            const char* a3 = a2 + kstep; const char* b3 = b2 + kstep;
            if (last && has_next) { S.a_ready(nxt); if constexpr (Epi::PREFETCH) E.pre(nxt, (ui + 1) & 1, wid, lane); }
            if constexpr (SP2) {
            PG8_LDB(B0, 0, 0); PG8_LDB(B1, 0, 1); PG8_SCHED; PG8_LDA(At, 0, 0); PG8_STAGE(PG8_SA(1, 1), a1 + hstep, voffA);
            PG8_WAIT_V(8); PG8_WAIT_L(0); PG8_BAR; PG8_MMA(0, 0, At, B0); PG8_MMA(0, 1, At, B1); PG8_BAR; PG8_SCHED;
            PG8_LDA(At, 0, 1); PG8_STAGE(PG8_SB(0, 0), b2, voffB); PG8_STAGE(PG8_SB(0, 1), b2 + hstep, voffB); PG8_STAGE(PG8_SA(0, 0), a2, voffA);
            PG8_WAIT_V(8); PG8_WAIT_L(0); PG8_BAR; PG8_MMA(1, 0, At, B0); PG8_MMA(1, 1, At, B1); PG8_BAR; PG8_SCHED;
            PG8_LDB(B0, 1, 0); PG8_LDB(B1, 1, 1); PG8_SCHED; PG8_LDA(At, 1, 0); PG8_STAGE(PG8_SA(0, 1), a2 + hstep, voffA);
            PG8_WAIT_V(8); PG8_WAIT_L(0); PG8_BAR; PG8_MMA(0, 0, At, B0); PG8_MMA(0, 1, At, B1); PG8_BAR; PG8_SCHED;
            PG8_LDA(At, 1, 1); PG8_STAGE(PG8_SB(1, 0), b3, voffB); PG8_STAGE(PG8_SB(1, 1), b3 + hstep, voffB); PG8_STAGE(PG8_SA(1, 0), a3, voffA);
            PG8_WAIT_V(8); PG8_WAIT_L(0); PG8_BAR; PG8_MMA(1, 0, At, B0); PG8_MMA(1, 1, At, B1); PG8_BAR; PG8_SCHED;
            } else {
            PG8_LDB(B0, 0, 0); PG8_SCHED; PG8_LDA(At, 0, 0); PG8_STAGE(PG8_SA(1, 1), a1 + hstep, voffA);
            PG8_WAIT_L(8); PG8_BAR; PG8_WAIT_L(0); PG8_MMA(0, 0, At, B0); PG8_BAR; PG8_SCHED;
            PG8_LDB(B1, 0, 1); PG8_STAGE(PG8_SB(0, 0), b2, voffB);
            PG8_BAR; PG8_WAIT_L(0); PG8_MMA(0, 1, At, B1); PG8_BAR;
            PG8_LDA(At, 0, 1); PG8_STAGE(PG8_SA(0, 0), a2, voffA);
            PG8_BAR; PG8_WAIT_L(0); PG8_MMA(1, 0, At, B0); PG8_BAR; PG8_SCHED;
            PG8_STAGE(PG8_SB(0, 1), b2 + hstep, voffB);
            PG8_WAIT_V(6); PG8_BAR; PG8_MMA(1, 1, At, B1); PG8_BAR;
            PG8_LDB(B0, 1, 0); PG8_SCHED; PG8_LDA(At, 1, 0); PG8_STAGE(PG8_SA(0, 1), a2 + hstep, voffA);
            PG8_WAIT_L(8); PG8_BAR; PG8_WAIT_L(0); PG8_MMA(0, 0, At, B0); PG8_BAR; PG8_SCHED;
            PG8_LDB(B1, 1, 1); PG8_STAGE(PG8_SB(1, 0), b3, voffB);
            PG8_BAR; PG8_WAIT_L(0); PG8_MMA(0, 1, At, B1); PG8_BAR;
            PG8_LDA(At, 1, 1); PG8_STAGE(PG8_SA(1, 0), a3, voffA);
            PG8_BAR; PG8_WAIT_L(0); PG8_MMA(1, 0, At, B0); PG8_BAR; PG8_SCHED;
            PG8_STAGE(PG8_SB(1, 1), b3 + hstep, voffB);
            PG8_WAIT_V(6); PG8_BAR; PG8_MMA(1, 1, At, B1); PG8_BAR;
            }
        }
        if constexpr (ALIGN_EPI) { if (wr == 0) PG8_BAR; }
        if constexpr (Epi::PREFETCH) { E.ep(acc, cur, wr, wc, fr, fq, ui & 1); S.done(cur); }
        else if constexpr (!Epi::AFTER_DRAIN) { E(acc, cur, wr, wc, fr, fq); S.done(cur); }
        if (!has_next) break;
#pragma unroll
        for (int a = 0; a < 2; ++a)
#pragma unroll
            for (int b = 0; b < 2; ++b)
#pragma unroll
                for (int m = 0; m < 4; ++m)
#pragma unroll
                    for (int n = 0; n < 2; ++n) acc[a][b][m][n] = (f32x4){0.f, 0.f, 0.f, 0.f};
        cur = nxt; cA = nA; cB = nB; ++ui;
        if constexpr (ALIGN_EPI) { if (wr == 1) PG8_BAR; }
    }
    PG8_WAIT_V(0);
    if constexpr (!ALIGN_EPI) { if (wr == 0) PG8_BAR; }
    PG8_BAR;
    if constexpr (Epi::AFTER_DRAIN) { E.fused(acc, cur, wr, wc, fr, fq, lds, wid, lane); S.done(cur); }
#undef PG8_SA
#undef PG8_SB
#undef PG8_STAGE
#undef PG8_LDA
#undef PG8_LDB
#undef PG8_MMA
#undef PG8_WAIT_V
#undef PG8_WAIT_L
#undef PG8_BAR
#undef PG8_SCHED
}
}
namespace att {
using bf16 = __hip_bfloat16;
using bf16x8 = __attribute__((ext_vector_type(8))) short;
using s16x4 = __attribute__((ext_vector_type(4))) short;
using f32x16 = __attribute__((ext_vector_type(16))) float;
using u32x4 = __attribute__((ext_vector_type(4))) unsigned;
constexpr int SEQ = 4096, SLOTB = 8192;
constexpr int L_CK = 0, L_CV = 4 * SLOTB, L_K = 8 * SLOTB, L_V = 11 * SLOTB, L_WS = 14 * SLOTB, L_RK = L_WS + 8 * 256, L_OST = 0, L_YL = 0, ATT_LDS = L_RK + 8 * 2048;
typedef float f32x4_t __attribute__((ext_vector_type(4)));
constexpr float NEGBIG = -1e30f, FORCEV = 1e9f;
#define SBAR() __builtin_amdgcn_sched_barrier(0)
#define WAIT_BAR(N) asm volatile("s_waitcnt vmcnt(" #N ") lgkmcnt(0)\n\ts_barrier" ::: "memory")
__device__ __forceinline__ int crow(int r, int hi) { return (r & 3) + 8 * (r >> 2) + 4 * hi; }
__device__ __forceinline__ void glds16(const void* gsrc, unsigned lds_dst) { unsigned keep;
    asm volatile("s_mov_b32 %0, m0\n\ts_mov_b32 m0, %2\n\ts_nop 0\n\tglobal_load_lds_dwordx4 %1, off\n\ts_mov_b32 m0, %0" : "=&s"(keep) : "v"(gsrc), "s"(lds_dst) : "memory"); }
typedef float f32x2_t __attribute__((ext_vector_type(2))); typedef __bf16 bf16x2_t __attribute__((ext_vector_type(2)));
__device__ __forceinline__ unsigned cvtpk_s(float lo, float hi) { f32x2_t v = {lo, hi}; bf16x2_t b = __builtin_convertvector(v, bf16x2_t); return __builtin_bit_cast(unsigned, b); }
__device__ __forceinline__ float swap32f_(float v, int hi) { auto rr = __builtin_amdgcn_permlane32_swap(__float_as_uint(v), __float_as_uint(v), false, false); return __uint_as_float(hi ? rr[0] : rr[1]); }
#define swap32f(v) swap32f_((v), hi)
__device__ __forceinline__ void qkt(f32x16& p0, f32x16& p1, const char* Kslot, const bf16x8* qr, const f32x16& c0, int r32, int hi) {
    const char* kb = Kslot + hi * 1024 + r32 * 16;
    bf16x8 kf[8];
#pragma unroll
    for (int d0 = 0; d0 < 4; ++d0) { kf[2 * d0] = *reinterpret_cast<const bf16x8*>(kb + d0 * 2048); kf[2 * d0 + 1] = *reinterpret_cast<const bf16x8*>(kb + d0 * 2048 + 512); }
    SBAR();
    p0 = __builtin_amdgcn_mfma_f32_32x32x16_bf16(kf[0], qr[0], c0, 0, 0, 0); p1 = __builtin_amdgcn_mfma_f32_32x32x16_bf16(kf[1], qr[0], c0, 0, 0, 0);
#pragma unroll
    for (int d0 = 1; d0 < 4; ++d0) { p0 = __builtin_amdgcn_mfma_f32_32x32x16_bf16(kf[2 * d0], qr[d0], p0, 0, 0, 0); p1 = __builtin_amdgcn_mfma_f32_32x32x16_bf16(kf[2 * d0 + 1], qr[d0], p1, 0, 0, 0); }
    SBAR();
}
__device__ __forceinline__ void pv(f32x16* o, int vb, bf16x8 pa0, bf16x8 pa1, bf16x8 pa2, bf16x8 pa3) {
    s16x4 lo[8], hi[8];
#pragma unroll
    for (int d0 = 0; d0 < 2; ++d0)
#pragma unroll
        for (int ks = 0; ks < 4; ++ks) {
            asm volatile("ds_read_b64_tr_b16 %0,%1 offset:%c2" : "=&v"(lo[d0 * 4 + ks]) : "v"(vb), "i"(d0 * 4096 + ks * 1024) : "memory");
            asm volatile("ds_read_b64_tr_b16 %0,%1 offset:%c2" : "=&v"(hi[d0 * 4 + ks]) : "v"(vb), "i"(d0 * 4096 + ks * 1024 + 512) : "memory"); }
    asm volatile("s_waitcnt lgkmcnt(0)" ::: "memory"); SBAR();
#define PK(k) (bf16x8){lo[k][0], lo[k][1], lo[k][2], lo[k][3], hi[k][0], hi[k][1], hi[k][2], hi[k][3]}
#pragma unroll
    for (int d0 = 0; d0 < 2; ++d0) {
        o[d0] = __builtin_amdgcn_mfma_f32_32x32x16_bf16(pa0, PK(d0 * 4 + 0), o[d0], 0, 0, 0);
        o[d0] = __builtin_amdgcn_mfma_f32_32x32x16_bf16(pa1, PK(d0 * 4 + 1), o[d0], 0, 0, 0);
        o[d0] = __builtin_amdgcn_mfma_f32_32x32x16_bf16(pa2, PK(d0 * 4 + 2), o[d0], 0, 0, 0);
        o[d0] = __builtin_amdgcn_mfma_f32_32x32x16_bf16(pa3, PK(d0 * 4 + 3), o[d0], 0, 0, 0); }
#undef PK
}
__device__ __forceinline__ bf16x8 packp(const f32x16& p, int b, float sc) {
    u32x4 w; w.x = cvtpk_s(p[b] * sc, p[b + 1] * sc); w.y = cvtpk_s(p[b + 2] * sc, p[b + 3] * sc); w.z = cvtpk_s(p[b + 4] * sc, p[b + 5] * sc); w.w = cvtpk_s(p[b + 6] * sc, p[b + 7] * sc);
    return __builtin_bit_cast(bf16x8, w); }
__device__ __forceinline__ float dpp_xor1(float v) { return __int_as_float(__builtin_amdgcn_update_dpp(0, __float_as_int(v), 0xB1, 0xF, 0xF, false)); }
__device__ __forceinline__ float dpp_xor2(float v) { return __int_as_float(__builtin_amdgcn_update_dpp(0, __float_as_int(v), 0x4E, 0xF, 0xF, false)); }
__device__ __forceinline__ float sel4(int h4, float a, float b, float c, float d) { return h4 == 0 ? a : (h4 == 1 ? b : (h4 == 2 ? c : d)); }

#define FLASH flash_branch4
struct AttnPtrs { const bf16* Q; const bf16* CMPK; const bf16* CMPV; const bf16* KS; const bf16* VS; const bf16* KW; const bf16* VW; const float* GNSA; bf16* YB; };
struct AttnP { unsigned char* ws; const float* caw; const float* kng; };

#define ATT_DMA_K(base, tile, ldsoff) glds16((base) + (long)(tile) * 4096 + koff, (unsigned)__builtin_amdgcn_readfirstlane(lds0 + (unsigned)(ldsoff) + (unsigned)wid * 1024u))
#define ATT_DMA_V(base, tile, ldsoff) glds16((base) + (long)(tile) * 4096 + voff, (unsigned)__builtin_amdgcn_readfirstlane(lds0 + (unsigned)(ldsoff) + (unsigned)wid * 1024u))

typedef __attribute__((address_space(3))) const char* lds_cptr;
typedef short v4i16_t __attribute__((ext_vector_type(4)));
__device__ __forceinline__ s16x4 vtr(lds_cptr p) { return __builtin_bit_cast(s16x4, __builtin_amdgcn_ds_read_tr16_b64_v4i16((__attribute__((address_space(3))) v4i16_t*)p)); }
#define WAITV_BAR(N) asm volatile("s_waitcnt vmcnt(" #N ") lgkmcnt(0)\n\ts_barrier" ::: "memory")
#define F4_PIN(x) asm volatile("" : "+v"(x))
template <int MODE> __device__ __forceinline__ void flash_branch4(const bf16* Kb, const bf16* Vb, int b, int g, int c, unsigned sel_lo, unsigned sel_hi, const float* GNSA, const bf16* Q, const float* kgain, char* shm) {
    int tid = threadIdx.x; asm volatile("" : "+v"(tid));
    const int lane = tid & 63, r32 = lane & 31, hi = lane >> 5; const int wid = __builtin_amdgcn_readfirstlane(tid >> 6);
    const int qi = 8 * wid + (r32 >> 2), head = 4 * g + (r32 & 3); const long row = (long)b * SEQ + 64 * c + qi;
    const unsigned lds0 = (unsigned)(uintptr_t)shm; float* wsf = (float*)(shm + L_WS) + wid * 64; float* yl = (float*)(shm + L_YL) + wid * 2048 + lane;
    const int koff = lane * 64 + wid * 8, voff = (16 * (wid & 3) + (lane >> 2)) * 64 + (wid >> 2) * 32 + (lane & 3) * 8;
    const int vbl = ((lane >> 4) & 1) * 32 + (lane & 3) * 8 + (4 * hi + ((lane & 15) >> 2)) * 64;
    const float* gatep = GNSA + row * 24 + head * 3 + (MODE == 0 ? 1 : 2); const bf16* qp = Q + row * 512 + head * 64 + hi * 8;
    const int j0 = (MODE == 0) ? 0 : (c > 8 ? c - 8 : 0); const int NT = c - j0 + 1;
    float zz = 0.f; asm volatile("" : "+v"(zz));
    float mhat = 0.f; f32x16 o[2], negm, lac;
#pragma unroll
    for (int r = 0; r < 16; ++r) { o[0][r] = zz; o[1][r] = zz; negm[r] = zz; lac[r] = zz; }
    const bf16x8 ones = {16256, 16256, 16256, 16256, 16256, 16256, 16256, 16256};
    const lds_cptr kp0 = (lds_cptr)shm + L_K + hi * 1024 + r32 * 16;
    const lds_cptr vp0 = (lds_cptr)shm + L_V + vbl;
    bf16x8 kf[8]; f32x16 pA0, pA1, pB0, pB1; bool resc = false;
    s16x4 vlo[8], vhi[8]; u32x4 pw0, pw1, pw2, pw3;
    int sl_prev = 0, sl_cur = 0, sl_next = SLOTB;
#define F4_ROT() do { sl_prev = sl_cur; sl_cur = sl_next; sl_next = (sl_next == 2 * SLOTB) ? 0 : sl_next + SLOTB; } while (0)
#define F4_ALLOWED(t_) ((MODE != 0) ? true : (((j0 + (t_)) < 32) ? (((sel_lo >> (j0 + (t_))) & 1u) != 0u) : (((sel_hi >> (j0 + (t_) - 32)) & 1u) != 0u)))
#define F4_MASK(P0_, P1_, t_) do { const int j_ = j0 + (t_); \
        if (j_ == c) { _Pragma("unroll") for (int r = 0; r < 16; ++r) { const int kk = crow(r, hi); P0_[r] = (kk <= qi) ? P0_[r] : NEGBIG; P1_[r] = (kk + 32 <= qi) ? P1_[r] : NEGBIG; } } \
        else if (MODE == 1 && j_ == c - 8) { _Pragma("unroll") for (int r = 0; r < 16; ++r) { const int kk = crow(r, hi); P0_[r] = (kk > qi) ? P0_[r] : NEGBIG; P1_[r] = (kk + 32 > qi) ? P1_[r] : NEGBIG; } } } while (0)
#define F4_RMAX(C0_, C1_, rm_) do { float a_ = fmaxf(fmaxf(C0_[0], C0_[1]), C1_[0]), b_ = fmaxf(fmaxf(C0_[2], C0_[3]), C1_[1]); a_ = fmaxf(fmaxf(a_, C1_[2]), C1_[3]); \
        _Pragma("unroll") for (int r = 4; r < 16; r += 4) { a_ = fmaxf(fmaxf(a_, C0_[r]), C0_[r + 1]); b_ = fmaxf(fmaxf(b_, C0_[r + 2]), C0_[r + 3]); a_ = fmaxf(fmaxf(a_, C1_[r]), C1_[r + 1]); b_ = fmaxf(fmaxf(b_, C1_[r + 2]), C1_[r + 3]); } \
        rm_ = fmaxf(a_, b_); rm_ = fmaxf(rm_, swap32f(rm_)); } while (0)
#define F4_DECIDE(C0_, C1_, al_) do { if (track) { float rm_; F4_RMAX(C0_, C1_, rm_); rm_ = (al_) ? rm_ : NEGBIG; resc = false; \
        if (__builtin_expect(__any(rm_ > 8.0f), 0)) { const float dl = fmaxf(rm_, 0.f); mhat += dl; \
            _Pragma("unroll") for (int r = 0; r < 16; ++r) { C0_[r] -= dl; C1_[r] -= dl; } \
            _Pragma("unroll") for (int r = 0; r < 16; ++r) negm[r] = -mhat; F4_PIN(negm); \
            const float f_ = __builtin_amdgcn_exp2f(-dl); if (hi == 0) wsf[r32] = f_; resc = true; } } } while (0)
#define F4_RESC() do { if (resc) { asm volatile("s_waitcnt lgkmcnt(0)" ::: "memory"); \
        _Pragma("unroll") for (int r = 0; r < 16; ++r) { const float fr_ = wsf[crow(r, hi)]; o[0][r] *= fr_; o[1][r] *= fr_; lac[r] *= fr_; } } } while (0)
#define F4_PKW(P, B) (cvtpk_s(P[B], P[B + 1]) & pmask)
#define F4_PAF(k) __builtin_bit_cast(bf16x8, pw##k)
#define F4_VFR(i) (bf16x8){vlo[i][0], vlo[i][1], vlo[i][2], vlo[i][3], vhi[i][0], vhi[i][1], vhi[i][2], vhi[i][3]}
#define F4_MF(a, b, cc) __builtin_amdgcn_mfma_f32_32x32x16_bf16(a, b, cc, 0, 0, 0)
#define F4_GAPA(MFs, A0, A1, A2, A3, W0, W1, PW) do { MFs; W0; W1; F4_PIN(PW); SBAR(); } while (0)
#define F4_EX(v) __builtin_amdgcn_exp2f(v)
#define F4_GAPB(MFs, X, B) do { MFs; X[B] = F4_EX(X[B]); X[B + 1] = F4_EX(X[B + 1]); X[B + 2] = F4_EX(X[B + 2]); X[B + 3] = F4_EX(X[B + 3]); F4_PIN(X); SBAR(); } while (0)
#define F4_VRD(i) do { vlo[i] = vtr(vp_ + (((i) >> 2) * 4096 + ((i) & 3) * 1024)); vhi[i] = vtr(vp_ + (((i) >> 2) * 4096 + ((i) & 3) * 1024 + 512)); } while (0)
#define F4_KRD(G, jj) do { if (G) { const lds_cptr kp_ = kp0 + sl_next; kf[2 * (jj)] = *(const __attribute__((address_space(3))) bf16x8*)(kp_ + (jj) * 2048); kf[2 * (jj) + 1] = *(const __attribute__((address_space(3))) bf16x8*)(kp_ + (jj) * 2048 + 512); SBAR(); } } while (0)
#define F4_STEP(C0, C1, P0, P1, t_, FULL) do { SBAR(); const int tt_ = (t_); const bool GK = (FULL) || tt_ + 3 < NT, GV = (FULL) || tt_ + 1 < NT, GL = GV;     \
        const lds_cptr vp_ = vp0 + sl_prev; const bool al_cur = F4_ALLOWED(tt_); \
        F4_VRD(0); SBAR(); \
        F4_GAPA(C0 = F4_MF(kf[0], qr[0], negm), P0[2], P0[3], P0[4], P0[5], pw0[0] = F4_PKW(P0, 0), pw0[1] = F4_PKW(P0, 2), pw0); \
        F4_VRD(4); SBAR(); F4_GAPA(C1 = F4_MF(kf[1], qr[0], negm), P0[6], P0[7], P0[8], P0[9], pw0[2] = F4_PKW(P0, 4), pw0[3] = F4_PKW(P0, 6), pw0); \
        F4_VRD(1); SBAR(); F4_GAPA(C0 = F4_MF(kf[2], qr[1], C0), P0[10], P0[11], P0[12], P0[13], pw1[0] = F4_PKW(P0, 8), pw1[1] = F4_PKW(P0, 10), pw1); \
        F4_VRD(5); SBAR(); F4_GAPA(C1 = F4_MF(kf[3], qr[1], C1), P0[14], P0[15], P1[0], P1[1], pw1[2] = F4_PKW(P0, 12), pw1[3] = F4_PKW(P0, 14), pw1); \
        F4_GAPA(C0 = F4_MF(kf[4], qr[2], C0), P1[2], P1[3], P1[4], P1[5], pw2[0] = F4_PKW(P1, 0), pw2[1] = F4_PKW(P1, 2), pw2); \
        F4_GAPA(C1 = F4_MF(kf[5], qr[2], C1), P1[6], P1[7], P1[8], P1[9], pw2[2] = F4_PKW(P1, 4), pw2[3] = F4_PKW(P1, 6), pw2); \
        F4_GAPA(C0 = F4_MF(kf[6], qr[3], C0), P1[10], P1[11], P1[12], P1[13], pw3[0] = F4_PKW(P1, 8), pw3[1] = F4_PKW(P1, 10), pw3); \
        F4_GAPA(C1 = F4_MF(kf[7], qr[3], C1), P1[14], P1[15], 0.f, 0.f, pw3[2] = F4_PKW(P1, 12), pw3[3] = F4_PKW(P1, 14), pw3); \
        pmask = al_cur ? 0xffffffffu : 0u; \
        if (GK) { ATT_DMA_K(Kb, j0 + tt_ + 3, L_K + sl_cur); } if (GV) { ATT_DMA_V(Vb, j0 + tt_ + 1, L_V + sl_next); } \
        if (!(FULL)) { F4_MASK(C0, C1, tt_); } \
        F4_DECIDE(C0, C1, al_cur); \
        SBAR(); \
        F4_VRD(2); SBAR(); F4_GAPB(o[0] = F4_MF(F4_PAF(0), F4_VFR(0), o[0]), C0, 0); \
        F4_VRD(6); SBAR(); F4_GAPB(o[1] = F4_MF(F4_PAF(0), F4_VFR(4), o[1]); lac = F4_MF(F4_PAF(0), ones, lac), C0, 4); \
        F4_VRD(3); SBAR(); F4_KRD(GL, 0); F4_GAPB(o[0] = F4_MF(F4_PAF(1), F4_VFR(1), o[0]), C0, 8); \
        F4_VRD(7); SBAR(); F4_KRD(GL, 1); F4_GAPB(o[1] = F4_MF(F4_PAF(1), F4_VFR(5), o[1]); lac = F4_MF(F4_PAF(1), ones, lac), C0, 12); \
        F4_KRD(GL, 2); F4_GAPB(o[0] = F4_MF(F4_PAF(2), F4_VFR(2), o[0]), C1, 0); \
        F4_KRD(GL, 3); F4_GAPB(o[1] = F4_MF(F4_PAF(2), F4_VFR(6), o[1]); lac = F4_MF(F4_PAF(2), ones, lac), C1, 4); \
        F4_GAPB(o[0] = F4_MF(F4_PAF(3), F4_VFR(3), o[0]), C1, 8); \
        F4_GAPB(o[1] = F4_MF(F4_PAF(3), F4_VFR(7), o[1]); lac = F4_MF(F4_PAF(3), ones, lac), C1, 12);     \
        SBAR(); \
          \
        if (GK) { WAITV_BAR(2); } else if (GV) { WAITV_BAR(1); } else { WAITV_BAR(0); } \
        F4_RESC(); F4_ROT(); } while (0)
    {
    ATT_DMA_K(Kb, j0, L_K); ATT_DMA_V(Vb, j0, L_V);
    if (NT > 1) { ATT_DMA_K(Kb, j0 + 1, L_K + SLOTB); }
    if (NT > 2) { ATT_DMA_K(Kb, j0 + 2, L_K + 2 * SLOTB); } }
    bf16x8 qr[4];
#pragma unroll
    for (int d0 = 0; d0 < 4; ++d0) qr[d0] = *reinterpret_cast<const bf16x8*>(qp + d0 * 16);
    WAITV_BAR(0);
    bool track;
    { float qq = 0.f;
#pragma unroll
      for (int d0 = 0; d0 < 4; ++d0)
#pragma unroll
        for (int e = 0; e < 8; ++e) { const float v = __uint_as_float(((unsigned)(unsigned short)qr[d0][e]) << 16); qq += v * v; }
      qq += swap32f(qq);
      float gm = fabsf(kgain[lane]);
      gm = fmaxf(gm, dpp_xor1(gm)); gm = fmaxf(gm, dpp_xor2(gm));
#pragma unroll
      for (int o = 4; o < 64; o <<= 1) gm = fmaxf(gm, __shfl_xor(gm, o));
      track = !__all(sqrtf(qq) * 8.0f * gm < 40.0f); }
    qkt(pA0, pA1, shm + L_K, qr, negm, r32, hi);
    F4_MASK(pA0, pA1, 0);
    unsigned pmask = F4_ALLOWED(0) ? 0xffffffffu : 0u;
    F4_DECIDE(pA0, pA1, pmask != 0u);
#pragma unroll
    for (int r = 0; r < 16; ++r) { pA0[r] = F4_EX(pA0[r]); pA1[r] = F4_EX(pA1[r]); }
    WAITV_BAR(0);
    if (NT > 3) { ATT_DMA_K(Kb, j0 + 3, L_K); }
    if (NT > 1) { ATT_DMA_V(Vb, j0 + 1, L_V + SLOTB); }
    F4_ROT();
    if (NT > 1) { const lds_cptr kp_ = kp0 + sl_cur;
        kf[0] = *(const __attribute__((address_space(3))) bf16x8*)(kp_); kf[1] = *(const __attribute__((address_space(3))) bf16x8*)(kp_ + 512);
        kf[2] = *(const __attribute__((address_space(3))) bf16x8*)(kp_ + 2048); kf[3] = *(const __attribute__((address_space(3))) bf16x8*)(kp_ + 2560);
        kf[4] = *(const __attribute__((address_space(3))) bf16x8*)(kp_ + 4096); kf[5] = *(const __attribute__((address_space(3))) bf16x8*)(kp_ + 4608);
        kf[6] = *(const __attribute__((address_space(3))) bf16x8*)(kp_ + 6144); kf[7] = *(const __attribute__((address_space(3))) bf16x8*)(kp_ + 6656); }
    if (NT > 3) { WAITV_BAR(2); } else if (NT > 1) { WAITV_BAR(1); } else { WAITV_BAR(0); }
    int t = 1; bool lastB = false;
    for (; t + 4 < NT; t += 2) {
        F4_STEP(pB0, pB1, pA0, pA1, t, true);
        F4_STEP(pA0, pA1, pB0, pB1, t + 1, true);
    }
    while (t < NT) {
        F4_STEP(pB0, pB1, pA0, pA1, t, false); ++t; lastB = true;
        if (t >= NT) break;
        F4_STEP(pA0, pA1, pB0, pB1, t, false); ++t; lastB = false;
    }
    if (lastB) { pA0 = pB0; pA1 = pB1; }
    {
      pw0 = (u32x4){F4_PKW(pA0, 0), F4_PKW(pA0, 2), F4_PKW(pA0, 4), F4_PKW(pA0, 6)}; pw1 = (u32x4){F4_PKW(pA0, 8), F4_PKW(pA0, 10), F4_PKW(pA0, 12), F4_PKW(pA0, 14)};
      pw2 = (u32x4){F4_PKW(pA1, 0), F4_PKW(pA1, 2), F4_PKW(pA1, 4), F4_PKW(pA1, 6)}; pw3 = (u32x4){F4_PKW(pA1, 8), F4_PKW(pA1, 10), F4_PKW(pA1, 12), F4_PKW(pA1, 14)};
      SBAR(); pv(o, (int)(lds0 + L_V + sl_prev) + vbl, F4_PAF(0), F4_PAF(1), F4_PAF(2), F4_PAF(3));
      lac = F4_MF(F4_PAF(0), ones, lac); lac = F4_MF(F4_PAF(1), ones, lac); lac = F4_MF(F4_PAF(2), ones, lac); lac = F4_MF(F4_PAF(3), ones, lac); }
    if (hi == 0) wsf[r32] = *gatep;
    asm volatile("s_waitcnt lgkmcnt(0)" ::: "memory");
#pragma unroll
    for (int r = 0; r < 16; ++r) { const float fr_ = wsf[crow(r, hi)] * __builtin_amdgcn_rcpf(lac[r]); yl[r * 64] += o[0][r] * fr_; yl[(16 + r) * 64] += o[1][r] * fr_; }
    WAIT_BAR(0);
#undef F4_ROT
#undef F4_ALLOWED
#undef F4_MASK
#undef F4_RMAX
#undef F4_DECIDE
#undef F4_RESC
#undef F4_CV
#undef F4_PKW
#undef F4_PAF
#undef F4_VFR
#undef F4_MF
#undef F4_GAPA
#undef F4_EX
#undef F4_GAPB
#undef F4_VRD
#undef F4_KRD
#undef F4_STEP
}
#undef F4_PIN


template <int DRY> __device__ __forceinline__ void attn_unit(int b, int g, int c, const AttnP& PP, char* shm) {
    int tid = threadIdx.x; asm volatile("" : "+v"(tid));
    unsigned char* wsb = PP.ws; asm volatile("" : "+s"(wsb));
    const AttnPtrs P{(const bf16*)(wsb + WS_Q), (const bf16*)(wsb + WS_CMPK), (const bf16*)(wsb + WS_CMPV), (const bf16*)(wsb + WS_KS), (const bf16*)(wsb + WS_VS), (const bf16*)(wsb + WS_KW), (const bf16*)(wsb + WS_VW), (const float*)(wsb + WS_GNSA), (bf16*)(wsb + WS_YAB)};
    const int lane = tid & 63, r32 = lane & 31, hi = lane >> 5; const int wid = __builtin_amdgcn_readfirstlane(tid >> 6);
    const int qi = 8 * wid + (r32 >> 2), h4 = r32 & 3, head = 4 * g + h4;
    const int t = 64 * c + qi; const long row = (long)b * SEQ + t;
    const unsigned lds0 = (unsigned)(uintptr_t)shm;
    float* wsf = (float*)(shm + L_WS) + wid * 64;
    const long bg = (long)(b * 2 + g);
    const bf16* CKb = P.CMPK + bg * 256 * 64; const bf16* CVb = P.CMPV + bg * 256 * 64;
    const int koff = lane * 64 + wid * 8;
    const int voff = (16 * (wid & 3) + (lane >> 2)) * 64 + (wid >> 2) * 32 + (lane & 3) * 8;
    const int vbl = ((lane >> 4) & 1) * 32 + (lane & 3) * 8 + (4 * hi + ((lane & 15) >> 2)) * 64;
    const int nsl = (((4 * c + 2) >> 6) + 1 < 4) ? ((4 * c + 2) >> 6) + 1 : 4;
    for (int j = 0; j < nsl; ++j) { ATT_DMA_K(CKb, j, L_CK + j * SLOTB); ATT_DMA_V(CVb, j, L_CV + j * SLOTB); }
    const int chn = 256 * g + (tid & 31) * 8, rg = tid >> 5; const long t0 = (long)b * SEQ + 64 * c + 4 * rg;
    f32x4_t cw0[2], cw1[2], cw2[2]; u32x4 cp2 = {0u, 0u, 0u, 0u}, cp1 = cp2, ccu[4], cav[4];
    if (DRY == 0) {
        const bf16* ACX = (const bf16*)(wsb + WS_ACX); const bf16* AB = (const bf16*)(wsb + WS_AB);
#pragma unroll
        for (int j = 0; j < 2; ++j) { cw0[j] = *(const f32x4_t*)(PP.caw + chn + 4 * j); cw1[j] = *(const f32x4_t*)(PP.caw + 512 + chn + 4 * j); cw2[j] = *(const f32x4_t*)(PP.caw + 1024 + chn + 4 * j); }
        if (c != 0 || rg != 0) { cp2 = *(const u32x4*)(ACX + (t0 - 2) * 512 + chn); cp1 = *(const u32x4*)(ACX + (t0 - 1) * 512 + chn); }
#pragma unroll
        for (int rr = 0; rr < 4; ++rr) { ccu[rr] = *(const u32x4*)(ACX + (t0 + rr) * 512 + chn); cav[rr] = *(const u32x4*)(AB + (t0 + rr) * 512 + chn); }
    }
    bf16x8 qr[4];
#pragma unroll
    for (int d0 = 0; d0 < 4; ++d0) qr[d0] = *reinterpret_cast<const bf16x8*>(P.Q + row * 512 + head * 64 + d0 * 16 + hi * 8);
    const float g0 = P.GNSA[row * 24 + head * 3 + 0];
    f32x16 y[2]; y[0] = f32x16{}; y[1] = f32x16{};
    WAIT_BAR(0);
    if (DRY == 0) { bf16* YA = (bf16*)(wsb + WS_YAB) + 512;
#pragma unroll
        for (int rr = 0; rr < 4; ++rr) { const u32x4 cu = ccu[rr], av = cav[rr]; u32x4 ov;
#pragma unroll
            for (int q = 0; q < 4; ++q) { const int j2 = q >> 1, e = (2 * q) & 3;
                const float lo = cw0[j2][e] * __uint_as_float(cp2[q] << 16) + cw1[j2][e] * __uint_as_float(cp1[q] << 16) + cw2[j2][e] * __uint_as_float(cu[q] << 16);
                const float hi_ = cw0[j2][e + 1] * __uint_as_float(cp2[q] & 0xffff0000u) + cw1[j2][e + 1] * __uint_as_float(cp1[q] & 0xffff0000u) + cw2[j2][e + 1] * __uint_as_float(cu[q] & 0xffff0000u);
                ov[q] = cvtpk_s(lo * __uint_as_float(av[q] << 16), hi_ * __uint_as_float(av[q] & 0xffff0000u)); }
            *(u32x4*)(YA + (t0 + rr) * 1024 + chn) = ov; cp2 = cp1; cp1 = cu; }
        SBAR(); }
    unsigned sel_lo, sel_hi;
    {
        const f32x16 z = f32x16{};
        const int kmax = (t >= 31) ? ((t - 31) >> 4) : -1;
        float mref = 0.f, ls = 0.f, ogp = 0.f; float imp[32];
#pragma unroll
        for (int i = 0; i < 32; ++i) imp[i] = 0.f;
#pragma unroll
        for (int sl = 0; sl < 4; ++sl) if (sl < nsl) {
            f32x16 p0, p1; qkt(p0, p1, shm + L_CK + sl * SLOTB, qr, z, r32, hi);
            float tm = NEGBIG;
#pragma unroll
            for (int r = 0; r < 16; ++r) { const int k = 64 * sl + crow(r, hi); p0[r] = (k <= kmax) ? p0[r] : NEGBIG; p1[r] = (k + 32 <= kmax) ? p1[r] : NEGBIG; tm = fmaxf(tm, fmaxf(p0[r], p1[r])); }
            tm = fmaxf(tm, swap32f(tm));
            if (sl == 0) { mref = (tm > -1e29f) ? tm : 0.f; }
            else if (__any(tm - mref > 8.0f)) {
                const float dl = fmaxf(tm - mref, 0.f); mref += dl; const float f = __builtin_amdgcn_exp2f(-dl); ls *= f; ogp *= f;
#pragma unroll
                for (int i = 0; i < 32; ++i) imp[i] *= f;
                if (hi == 0) wsf[r32] = f;
                asm volatile("s_waitcnt lgkmcnt(0)" ::: "memory");
#pragma unroll
                for (int r = 0; r < 16; ++r) { const float fr_ = wsf[crow(r, hi)]; y[0][r] *= fr_; y[1][r] *= fr_; }
            }
#pragma unroll
            for (int r = 0; r < 16; ++r) { p0[r] = __builtin_amdgcn_exp2f(p0[r] - mref); p1[r] = __builtin_amdgcn_exp2f(p1[r] - mref); ls += p0[r] + p1[r]; }
#pragma unroll
            for (int w = 0; w < 2; ++w)
#pragma unroll
                for (int rg = 0; rg < 4; ++rg) { const int i = 8 * sl + 4 * w + rg; const f32x16& e = w ? p1 : p0;
                    const float gs = (e[4 * rg] + e[4 * rg + 1]) + (e[4 * rg + 2] + e[4 * rg + 3]); const float gl = e[4 * rg + 3];
                    const float og = swap32f(gl);
                    imp[i] = gs + (hi ? og : ogp); ogp = og; }
            const bf16x8 pa0 = packp(p0, 0, 1.f), pa1 = packp(p0, 8, 1.f), pa2 = packp(p1, 0, 1.f), pa3 = packp(p1, 8, 1.f);
            SBAR();
            pv(y, (int)(lds0 + L_CV + sl * SLOTB) + vbl, pa0, pa1, pa2, pa3);
            SBAR();
        }
        ls += swap32f(ls);
        const float inv = ls > 0.f ? 1.0f / ls : 0.f;
        if (hi == 0) wsf[r32] = g0 * inv;
        asm volatile("s_waitcnt lgkmcnt(0)" ::: "memory");
#pragma unroll
        for (int r = 0; r < 16; ++r) { const float fr_ = wsf[crow(r, hi)]; y[0][r] *= fr_; y[1][r] *= fr_; }
        unsigned mlo = 0xffffffffu, mhi = 0xffffffffu;
        if (c >= 16) { mlo = 0u; mhi = 0u;
        unsigned* rk = (unsigned*)(shm + L_RK) + wid * 512 + (r32 >> 2) * 64;
        const int jb = 16 * h4 + hi;
#pragma unroll
        for (int i = 0; i < 32; ++i) { float v = imp[i] * inv; v += dpp_xor1(v); v += dpp_xor2(v);
            const int jc = 2 * i + hi;
            unsigned key = (__float_as_uint(v) & 0xFFFFFFC0u) | (unsigned)(63 - jc);
            key = (jc == 0 || jc == c || jc == c - 1) ? (0xFFFFFFC0u | (unsigned)(63 - jc)) : (jc <= c ? key : (unsigned)(63 - jc));
            rk[jc] = key; }
        asm volatile("s_waitcnt lgkmcnt(0)" ::: "memory");
        int rank[8]; unsigned cand[8];
#pragma unroll
        for (int u = 0; u < 8; ++u) { rank[u] = 0; cand[u] = rk[jb + 2 * u]; }
        const int nch = (c >> 2) + 1;
#pragma unroll 4
        for (int ch = 0; ch < nch; ++ch) { const u32x4 v4 = *(const u32x4*)(rk + 4 * ch);
#pragma unroll
            for (int e = 0; e < 4; ++e) { const unsigned v = v4[e];
#pragma unroll
                for (int u = 0; u < 8; ++u) rank[u] += (v > cand[u]) ? 1 : 0; } }
#pragma unroll
        for (int u = 0; u < 8; ++u) { const int jc = jb + 2 * u; if (rank[u] < 16) { if (jc < 32) mlo |= 1u << jc; else mhi |= 1u << (jc - 32); } }
        mlo |= __float_as_uint(dpp_xor1(__uint_as_float(mlo))); mlo |= __float_as_uint(dpp_xor2(__uint_as_float(mlo))); mlo |= __float_as_uint(swap32f(__uint_as_float(mlo)));
        mhi |= __float_as_uint(dpp_xor1(__uint_as_float(mhi))); mhi |= __float_as_uint(dpp_xor2(__uint_as_float(mhi))); mhi |= __float_as_uint(swap32f(__uint_as_float(mhi)));
        }
        const unsigned vlo = (c >= 31) ? 0xffffffffu : ((2u << c) - 1u);
        const unsigned vhi = (c < 32) ? 0u : ((c >= 63) ? 0xffffffffu : ((2u << (c - 32)) - 1u));
        sel_lo = mlo & vlo; sel_hi = mhi & vhi;
#ifdef SELFCHECK
        if (h4 == 0 && hi == 0 && DRY == 0) { unsigned* mk = (unsigned*)(wsb + (58u << 20)) + ((size_t)row * 2 + g) * 2; mk[0] = sel_lo; mk[1] = sel_hi; }
#endif
    }
    SBAR();
    asm volatile("s_waitcnt vmcnt(0) lgkmcnt(0)\n\ts_barrier" ::: "memory");
    if (DRY == 1) { asm volatile("" :: "v"(sel_lo), "v"(sel_hi), "v"(y[0]), "v"(y[1])); asm volatile("s_waitcnt vmcnt(0) lgkmcnt(0)\n\ts_barrier" ::: "memory"); return; }
    float* yl = (float*)(shm + L_YL) + wid * 2048 + lane;
#pragma unroll
    for (int r = 0; r < 16; ++r) { yl[r * 64] = y[0][r]; yl[(16 + r) * 64] = y[1][r]; }
    const bf16* KSb = P.KS + bg * SEQ * 64; const bf16* VSb = P.VS + bg * SEQ * 64; const bf16* KWb = P.KW + bg * SEQ * 64; const bf16* VWb = P.VW + bg * SEQ * 64;
#ifndef NO_FLASH0
    if (DRY != 2)
    FLASH<0>(KSb, VSb, b, g, c, sel_lo, sel_hi, P.GNSA, P.Q, PP.kng + 64, shm);
#else
    y[0][0] += (float)(sel_lo ^ sel_hi);
#endif
#ifndef NO_FLASH1
    if (DRY != 3 && DRY < 4)
    FLASH<1>(KWb, VWb, b, g, c, 0u, 0u, P.GNSA, P.Q, PP.kng + 128, shm);
#endif
    {   int tid2 = threadIdx.x; asm volatile("" : "+v"(tid2)); const int lane = tid2 & 63, r32 = lane & 31, hi = lane >> 5; const int wid = __builtin_amdgcn_readfirstlane(tid2 >> 6); float* yl = (float*)(shm + L_YL) + wid * 2048 + lane;
#pragma unroll
        for (int r = 0; r < 16; ++r) { y[0][r] = yl[r * 64]; y[1][r] = yl[(16 + r) * 64]; }
        asm volatile("s_waitcnt lgkmcnt(0)" ::: "memory");
        bf16* stg = (bf16*)(shm + L_OST) + wid * 4096;
#pragma unroll
        for (int r = 0; r < 16; ++r) { const int orow = crow(r, hi);
#pragma unroll
            for (int d0 = 0; d0 < 2; ++d0) stg[orow * 64 + d0 * 32 + r32] = __float2bfloat16(y[d0][r]); }
        asm volatile("s_waitcnt lgkmcnt(0)" ::: "memory");
#pragma unroll
        for (int i = 0; i < 4; ++i) { const int rowl = i * 8 + (lane >> 3), ch = lane & 7; const u32x4 v = *(const u32x4*)(stg + rowl * 64 + ch * 8);
            bf16* dst = P.YB + ((long)b * SEQ + 64 * c + 8 * wid + (rowl >> 2)) * 1024 + (4 * g + (rowl & 3)) * 64 + ch * 8; *(u32x4*)dst = v; }
    }
    asm volatile("s_waitcnt lgkmcnt(0)\n\ts_barrier" ::: "memory");
}
#undef SBAR
#undef WAIT_BAR
#undef swap32f
}
constexpr int NWAVES = 8;
#ifndef MK_N_LAUNCHES
#define MK_N_LAUNCHES 1
#endif
constexpr int N_PHASES = 8;
constexpr int N_LAUNCHES = MK_N_LAUNCHES;
constexpr int RING_OFF = 0, RING_BYTES = 131072, ATT_BYTES = 133120, LDSCTL_OFF = ATT_BYTES, MISC_OFF = LDSCTL_OFF + 320, LDS_BYTES = 147456;
static_assert(att::ATT_LDS <= ATT_BYTES && RING_BYTES <= ATT_BYTES && LDSCTL_OFF + 1024 + 4096 + 2048 + 4096 <= LDS_BYTES, "LDS map");

#define GAS __attribute__((address_space(1)))
#define LAS __attribute__((address_space(3)))
typedef unsigned short bf16;
typedef unsigned v4u __attribute__((ext_vector_type(4)));
typedef float f32x4 __attribute__((ext_vector_type(4)));
typedef short bf16x8 __attribute__((ext_vector_type(8)));
typedef GAS unsigned gu32;
#define RLX_AGENT __ATOMIC_RELAXED, __HIP_MEMORY_SCOPE_AGENT
#define LDS_WAIT() asm volatile("s_waitcnt lgkmcnt(0)" ::: "memory")
#define VM_WAIT() asm volatile("s_waitcnt vmcnt(0)" ::: "memory")
__device__ __forceinline__ unsigned f2bf(float f) { unsigned u = __builtin_bit_cast(unsigned, f); return (u + 0x7fffu + ((u >> 16) & 1u)) >> 16; }
__device__ __forceinline__ unsigned pk2(float lo, float hi) { return f2bf(lo) | (f2bf(hi) << 16); }
__device__ __forceinline__ float bflo(unsigned w) { return __uint_as_float(w << 16); }
__device__ __forceinline__ float bfhi(unsigned w) { return __uint_as_float(w & 0xffff0000u); }
#define XB_TMO      128
#define XB_XCNT(j)  (256  + 64 * (j))
#define XB_XSUB(j)  (1280 + 64 * (j))
#define XB_XGEN(j)  (2304 + 64 * (j))
#define XB_TOP      3328
#define XB_TOPGEN   3392
#define XCD_BAR_WORDS 3456
#ifdef SELFCHECK
#define XB_SPIN_CAP (1u << 25)
#else
#define XB_SPIN_CAP (1u << 18)
#endif

__device__ __forceinline__ unsigned xb_ld(unsigned* p)              { return __hip_atomic_load(p, __ATOMIC_RELAXED, __HIP_MEMORY_SCOPE_AGENT); }
__device__ __forceinline__ unsigned xb_add(unsigned* p, unsigned v) { return __hip_atomic_fetch_add(p, v, __ATOMIC_RELAXED, __HIP_MEMORY_SCOPE_AGENT); }
__device__ __forceinline__ unsigned xb_xcc_id() { return (unsigned)__builtin_amdgcn_s_getreg((3 << 11) | 20) & 0xFu; }
#define XB_SPIN(cond, bar) do { unsigned _sp = 0; while (cond) { __builtin_amdgcn_s_sleep(1); \
    if ((++_sp & 255u) == 0u) { if (xb_ld(&(bar)[XB_TMO])) break; if (_sp > XB_SPIN_CAP) { atomicAdd(&(bar)[XB_TMO], 1u); break; } } } } while (0)

struct XcdBarrier {
    unsigned* bar; unsigned x;
    volatile LAS unsigned* st;
};

__device__ __forceinline__ XcdBarrier xcd_barrier_post(unsigned* bar, volatile LAS unsigned* st) {
    XcdBarrier b; b.bar = bar; b.x = xb_xcc_id(); b.st = st;
    if (threadIdx.x == 0) (void)xb_add(&bar[XB_XCNT(b.x)], 1u);
    return b;
}
__device__ __forceinline__ void xcd_barrier_complete(unsigned* bar, unsigned x, unsigned& nloc, unsigned& nx) {
    const unsigned G = gridDim.x * gridDim.y * gridDim.z;
    unsigned sum, cnt, mine, sp = 0u;
    for (;;) {
        sum = 0u; cnt = 0u; mine = 0u;
#pragma unroll
        for (unsigned j = 0; j < 16; ++j) { const unsigned c = xb_ld(&bar[XB_XCNT(j)]); sum += c; cnt += (c > 0u) ? 1u : 0u; mine = (j == x) ? c : mine; }
        if (sum == G) break;
        __builtin_amdgcn_s_sleep(1);
        if ((++sp & 255u) == 0u) { if (xb_ld(&bar[XB_TMO])) break; if (sp > XB_SPIN_CAP) { atomicAdd(&bar[XB_TMO], 1u); break; } }
    }
    nloc = mine > 0u ? mine : 1u; nx = cnt > 0u ? cnt : 1u;
}

__device__ __forceinline__ void xcd_barrier(const XcdBarrier& b) {
    asm volatile("s_waitcnt vmcnt(0)" ::: "memory");
    __syncthreads();
    if (threadIdx.x == 0) {
        unsigned* bar = b.bar;
        __builtin_amdgcn_s_waitcnt(0);
        unsigned nloc = b.st[0], nx = b.st[1];
        if (nloc == 0u) { xcd_barrier_complete(bar, b.x, nloc, nx); b.st[0] = nloc; b.st[1] = nx; }
        const unsigned old = xb_add(&bar[XB_XSUB(b.x)], 1u);
        const unsigned gen = old / nloc;
        if (old + 1u == (gen + 1u) * nloc) {
            __builtin_amdgcn_fence(__ATOMIC_RELEASE, "agent");
            asm volatile("s_waitcnt vmcnt(0)" ::: "memory");
            const unsigned og = xb_add(&bar[XB_TOP], 1u);
            const unsigned tg = og / nx;
            if (og + 1u == (tg + 1u) * nx) xb_add(&bar[XB_TOPGEN], 1u);
            else XB_SPIN(xb_ld(&bar[XB_TOPGEN]) == tg, bar);
            __builtin_amdgcn_fence(__ATOMIC_ACQUIRE, "agent");
            xb_add(&bar[XB_XGEN(b.x)], 1u);
            asm volatile("s_waitcnt vmcnt(0)" ::: "memory");
        } else {
            XB_SPIN(xb_ld(&bar[XB_XGEN(b.x)]) == gen, bar);
            __builtin_amdgcn_fence(__ATOMIC_ACQUIRE, "agent");
            asm volatile("s_waitcnt vmcnt(0)" ::: "memory");
        }
    }
    __syncthreads();
}

__device__ __forceinline__ float wave_sum(float v) {
#pragma unroll
    for (int o = 1; o < 64; o <<= 1) v += __shfl_xor(v, o);
    return v;
}
__device__ __forceinline__ int in_src_col(int np, int& nvalid) {
    const int pn = np >> 8, p = np & 255, bj = p >> 7, wc = (p >> 5) & 3; nvalid = 32;
    if (pn < 2) return np;
    if (pn < 6) return (bj == 0 ? 512 : 1024) + 128 * (pn - 2) + (p & 127);
    if (pn < 8) return 1536 + (4 * (pn - 6) + wc) * 64 + 32 * bj;
    if (pn == 8) return (wc < 2 ? 2304 : 2560) + (wc & 1) * 64 + 32 * bj;
    if (pn == 9) return (wc < 2 ? 2048 : 2176) + (wc & 1) * 64 + 32 * bj;
    if (pn == 10) return (wc < 2 ? 2432 : 2688) + (wc & 1) * 64 + 32 * bj;
    if (pn == 11) { nvalid = (p == 0) ? 24 : 0; return 2816; }
    return 2840 + (np - 3072);
}
__device__ __forceinline__ void transpose_item(const float* W, int ldw, int col0, int nvalid, const float* ks, bf16* WT, int ldk, int drow0, int k0, LAS float* scr, int lane, int kd = 0) {
    { const int c4 = lane & 7, n = 4 * c4; f32x4 v[8];
#pragma unroll
      for (int i = 0; i < 8; ++i) { const int kk = 8 * i + (lane >> 3); v[i] = (f32x4){0.f, 0.f, 0.f, 0.f}; if (n < nvalid) v[i] = __builtin_nontemporal_load((const GAS f32x4*)(W + (size_t)(k0 + kk) * ldw + col0 + n)); }
#pragma unroll
      for (int i = 0; i < 8; ++i) { const int kk = 8 * i + (lane >> 3); f32x4 w = v[i]; if (ks) w = w * ks[k0 + kk];
        scr[kk * 33 + n] = w.x; scr[kk * 33 + n + 1] = w.y; scr[kk * 33 + n + 2] = w.z; scr[kk * 33 + n + 3] = w.w; } }
    LDS_WAIT(); asm volatile("" ::: "memory");
    const int c = lane & 7;
#pragma unroll
    for (int j = 0; j < 4; ++j) { const int n = (lane >> 3) + 8 * j; const LAS float* s = scr + (8 * c) * 33 + n;
        v4u o; o.x = pk2(s[0 * 33], s[1 * 33]); o.y = pk2(s[2 * 33], s[3 * 33]); o.z = pk2(s[4 * 33], s[5 * 33]); o.w = pk2(s[6 * 33], s[7 * 33]);
        *(GAS v4u*)(WT + (size_t)(drow0 + n) * ldk + kd + k0 + 8 * c) = o; }
    LDS_WAIT(); asm volatile("" ::: "memory");
}
struct Ptrs {
    const float *x, *n1g, *win, *caw, *wa, *qng, *kng, *kpe, *kw1, *kw2, *vpe, *vw1, *vw2, *wb, *wo, *n2g, *wff, *fcw, *fcb, *wdn; const int* pos;
    float* out; unsigned char* ws;
};
__device__ __forceinline__ void p0_prologue(const Ptrs& P, LAS unsigned char* lds, int vcu, int G, int wave, int lane) {
    LAS float* scr = (LAS float*)(lds + RING_OFF + wave * 16384);
    const int gw = vcu * NWAVES + wave, NGW = G * NWAVES;
    unsigned char* ws = P.ws;
    constexpr int I_IN = (NIN / 32) * (DM / 64), I_A = (DM / 32) * (CW / 64), I_B = I_A, I_O = (DM / 32) * (DM / 64), I_FF = (NFF / 32) * (DM / 64), I_DN = (DM / 32) * (DFF / 64), I_W1 = 2 * (2048 / 64);
    constexpr int NITEMS = I_IN + I_A + I_B + I_O + I_FF + I_DN + 2 * I_W1;
    for (int it = gw; it < NITEMS; it += NGW) {
        int r = it;
        if (r < I_IN) { const int nb = r % (NIN / 32), kb = r / (NIN / 32); int nv; const int sc = in_src_col(32 * nb, nv); transpose_item(P.win, INCOLS, sc, nv, nullptr, (bf16*)(ws + WS_WIN), DM, 32 * nb, 64 * kb, scr, lane); continue; } r -= I_IN;
        if (r < I_A) { const int nb = r % (DM / 32), kb = r / (DM / 32); transpose_item(P.wa, DM, 32 * nb, 32, nullptr, (bf16*)(ws + WS_WA), DM, 32 * nb, 64 * kb, scr, lane, CW); continue; } r -= I_A;
        if (r < I_B) { const int nb = r % (DM / 32), kb = r / (DM / 32); transpose_item(P.wb, DM, 32 * nb, 32, nullptr, (bf16*)(ws + WS_WA), DM, 32 * nb, 64 * kb, scr, lane, 0); continue; } r -= I_B;
        if (r < I_O) { const int nb = r % (DM / 32), kb = r / (DM / 32); transpose_item(P.wo, DM, 32 * nb, 32, nullptr, (bf16*)(ws + WS_WO), DM, 32 * nb, 64 * kb, scr, lane); continue; } r -= I_O;
        if (r < I_FF) { const int nb = r % (NFF / 32), kb = r / (NFF / 32); const int np = 32 * nb, tile = np >> 8, p = np & 255;
            const int sc = (p < 128) ? (128 * tile + p) : (DFF + 128 * tile + p - 128);
            transpose_item(P.wff, NFF, sc, 32, P.n2g, (bf16*)(ws + WS_WFF), DM, np, 64 * kb, scr, lane); continue; } r -= I_FF;
        if (r < I_DN) { const int nb = r % (DM / 32), kb = r / (DM / 32); transpose_item(P.wdn, DM, 32 * nb, 32, nullptr, (bf16*)(ws + WS_WDN), DFF, 32 * nb, 64 * kb, scr, lane); continue; } r -= I_DN;
        if (r < I_W1) { const int nb = r % 2, kb = r / 2; transpose_item(P.kw1, 64, 32 * nb, 32, nullptr, (bf16*)(ws + WS_W1K), 2048, 32 * nb, 64 * kb, scr, lane); continue; } r -= I_W1;
        { const int nb = r % 2, kb = r / 2; transpose_item(P.vw1, 64, 32 * nb, 32, nullptr, (bf16*)(ws + WS_W1V), 2048, 32 * nb, 64 * kb, scr, lane); }
    }
    { const GAS f32x4* gp = (const GAS f32x4*)P.n1g + lane; f32x4 gv[4];
#pragma unroll
      for (int j = 0; j < 4; ++j) gv[j] = gp[64 * j];
      bf16* H1 = (bf16*)(ws + WS_H1);
      for (int m0 = gw; m0 < T; m0 += 4 * NGW) {
        f32x4 v[4][4];
#pragma unroll
        for (int r = 0; r < 4; ++r) { const int m = (m0 + r * NGW < T) ? m0 + r * NGW : m0; const GAS f32x4* xr = (const GAS f32x4*)(P.x + (size_t)m * DM) + lane;
#pragma unroll
          for (int j = 0; j < 4; ++j) v[r][j] = __builtin_nontemporal_load(xr + 64 * j); }
#pragma unroll
        for (int r = 0; r < 4; ++r) { const int m = m0 + r * NGW; if (m < T) { float s = 0.f;
#pragma unroll
          for (int j = 0; j < 4; ++j) s += (v[r][j].x * v[r][j].x + v[r][j].y * v[r][j].y) + (v[r][j].z * v[r][j].z + v[r][j].w * v[r][j].w);
          const float rs = 1.0f / sqrtf(wave_sum(s) * (1.0f / DM) + 1e-6f);
          GAS unsigned long long* o8 = (GAS unsigned long long*)(H1 + (size_t)m * DM) + lane;
#pragma unroll
          for (int j = 0; j < 4; ++j) { const f32x4 y = v[r][j] * rs * gv[j]; o8[64 * j] = (unsigned long long)pk2(y.x, y.y) | ((unsigned long long)pk2(y.z, y.w) << 32); } } }
      } }
    { float* CS = (float*)(ws + WS_CS); const int gt = gw * 64 + lane, NT = NGW * 64;
      const float inv = powf(10000.0f, -(float)(gt & 31) / 32.0f);
      for (int e = gt; e < T * 32; e += NT) { const int row = e >> 5, i = e & 31;
        const float ang = (float)P.pos[row] * inv;
        float sn, cs; sincosf(ang, &sn, &cs); CS[(size_t)row * 64 + i] = cs; CS[(size_t)row * 64 + 32 + i] = sn; } }
    if (gw < 128) { const int kv = gw >> 6, n = gw & 63; const float* pe = kv ? P.vpe : P.kpe; const float* w1 = kv ? P.vw1 : P.kw1; float s = 0.f;
        for (int k = lane; k < 2048; k += 64) s += pe[k] * w1[(size_t)k * 64 + n];
        s = wave_sum(s); if (lane == 0) ((float*)(ws + WS_CB))[gw] = s; }
}
__device__ __forceinline__ void compress_unit(const Ptrs& P, int u, LAS unsigned char* lds, int tid) {
    const int kv = u >> 7, bg = (u >> 3) & 15, rc = u & 7;
    const int lane = tid & 63, w = tid >> 6, ct = w & 3, kh = w >> 2, r = lane & 15, q = lane >> 4;
    const bf16* A = (const bf16*)(P.ws + (kv ? WS_VC : WS_KC)) + (size_t)bg * SEQ * 64;
    const bf16* Bt = (const bf16*)(P.ws + (kv ? WS_W1V : WS_W1K));
    const float* cb = (const float*)(P.ws + WS_CB) + kv * 64;
    const float* w2 = kv ? P.vw2 : P.kw2;
    LAS unsigned char* al = lds + RING_OFF;
    LAS float* hid = (LAS float*)(lds + RING_OFF + 69632);
    LAS float* w2l = (LAS float*)(lds + RING_OFF + 69632 + 16640);
    { const bf16* As = A + (size_t)(32 * rc) * 1024; const unsigned l0 = (unsigned)(uintptr_t)(lds + RING_OFF); const int wu = __builtin_amdgcn_readfirstlane(w);
      for (int j = wu; j < 66; j += NWAVES) att::glds16(As + (size_t)j * 512 + lane * 8, (unsigned)__builtin_amdgcn_readfirstlane(l0 + (unsigned)(j * 1024 + 16 * (j >> 1))));
      for (int j = wu; j < 16; j += NWAVES) att::glds16(w2 + j * 256 + lane * 4, (unsigned)__builtin_amdgcn_readfirstlane(l0 + (unsigned)(69632 + 16640 + j * 1024))); }
    asm volatile("s_waitcnt vmcnt(0)" ::: "memory");
    __syncthreads();
    const bf16* bp = Bt + (size_t)(16 * ct + r) * 2048 + 8 * q + 1024 * kh;
    f32x4 acc0 = {0.f, 0.f, 0.f, 0.f}, acc1 = {0.f, 0.f, 0.f, 0.f};
#pragma unroll 8
    for (int s2 = 0; s2 < 32; ++s2) { const int s = 32 * kh + s2;
        const bf16x8 b0 = *(const bf16x8*)(bp + 32 * s2);
        const int t0 = 16 * r + (s >> 1), t1 = t0 + 256;
        const bf16x8 a0 = *(const LAS bf16x8*)(al + t0 * 128 + 16 * (t0 >> 4) + (s & 1) * 64 + 16 * q), a1 = *(const LAS bf16x8*)(al + t1 * 128 + 16 * (t1 >> 4) + (s & 1) * 64 + 16 * q);
        acc0 = __builtin_amdgcn_mfma_f32_16x16x32_bf16(a0, b0, acc0, 0, 0, 0); acc1 = __builtin_amdgcn_mfma_f32_16x16x32_bf16(a1, b0, acc1, 0, 0, 0);
    }
#pragma unroll
    for (int e = 0; e < 4; ++e) { hid[(kh * 32 + 4 * q + e) * 65 + 16 * ct + r] = acc0[e]; hid[(kh * 32 + 16 + 4 * q + e) * 65 + 16 * ct + r] = acc1[e]; }
    __syncthreads();
    for (int idx = tid; idx < 2048; idx += NWAVES * 64) { const int rl = idx >> 6, c0 = idx & 63;
        float h0 = hid[rl * 65 + c0] + hid[(32 + rl) * 65 + c0] + cb[c0]; h0 = h0 / (1.0f + __expf(-h0)); hid[rl * 65 + c0] = h0; }
    __syncthreads();
    { const int rl = tid >> 4, c4 = tid & 15; float o[4] = {0.f, 0.f, 0.f, 0.f};
      for (int k = 0; k < 64; ++k) { const float h = hid[rl * 65 + k]; const f32x4 wa = *(const LAS f32x4*)(w2l + k * 64 + 4 * c4);
        o[0] += h * wa.x; o[1] += h * wa.y; o[2] += h * wa.z; o[3] += h * wa.w; }
      if (kv == 0) { float ss = (o[0] * o[0] + o[1] * o[1]) + (o[2] * o[2] + o[3] * o[3]);
        ss += __shfl_xor(ss, 1); ss += __shfl_xor(ss, 2); ss += __shfl_xor(ss, 4); ss += __shfl_xor(ss, 8);
        const float rs = 1.0f / sqrtf(ss * (1.0f / 64.0f) + 1e-6f);
#pragma unroll
        for (int j = 0; j < 4; ++j) o[j] = o[j] * rs * P.kng[4 * c4 + j]; }
      const int i = 32 * rc + rl;
      if (i == 255) { o[0] = 0.f; o[1] = 0.f; o[2] = 0.f; o[3] = 0.f; }
      bf16* dst = (bf16*)(P.ws + (kv ? WS_CMPV : WS_CMPK)) + ((size_t)bg * 256 + i) * 64 + 4 * c4;
      *(unsigned long long*)dst = (unsigned long long)pk2(o[0], o[1]) | ((unsigned long long)pk2(o[2], o[3]) << 32); }
    __syncthreads();
}
__device__ __forceinline__ void ffn_fix_rows(unsigned char* ws, const float* cw, int pm, int tid) {
    const float* TAIL = (const float*)(ws + WS_TAIL); const float* HP = (const float*)(ws + WS_HEADP); const float* HU = (const float*)(ws + WS_HEADU); bf16* ACT = (bf16*)(ws + WS_ACT);
    const bool first = (pm & 15) == 0;
    constexpr int NI = 2 * DFF / (NWAVES * 64);
    static_assert(NI * NWAVES * 64 == 2 * DFF, "fix-rows item count");
    float t0[NI], t1[NI], w0[NI], w1[NI], hp[NI], hu[NI];
#pragma unroll
    for (int j = 0; j < NI; ++j) { const int idx = tid + j * NWAVES * 64, fr = idx >= DFF ? 1 : 0, ch = idx - fr * DFF;
        t0[j] = first ? 0.f : TAIL[((size_t)(pm - 1) * 2 + 0) * DFF + ch]; t1[j] = first ? 0.f : TAIL[((size_t)(pm - 1) * 2 + 1) * DFF + ch];
        w0[j] = cw[ch]; w1[j] = cw[DFF + ch]; hp[j] = HP[((size_t)pm * 2 + fr) * DFF + ch]; hu[j] = HU[((size_t)pm * 2 + fr) * DFF + ch]; }
#pragma unroll
    for (int j = 0; j < NI; ++j) { const int idx = tid + j * NWAVES * 64, fr = idx >= DFF ? 1 : 0, ch = idx - fr * DFF;
        const float pre = hp[j] + (fr == 0 ? (w0[j] * t0[j] + w1[j] * t1[j]) : (w0[j] * t1[j]));
        const float a = pre / (1.0f + exp2f(pre)) * hu[j];
        ACT[((size_t)pm * 256 + fr) * DFF + ch] = (bf16)f2bf(a); }
}
#ifdef SELFCHECK
constexpr size_t WS_CHKMASK = 58 * MiB;
constexpr size_t WS_CHKSLAB = 128 * MiB;
constexpr int CHK_NS = 4096;
constexpr int CW_CHK = 8192;
#ifndef CHK_MAXMASK
#define CHK_MAXMASK 40u
#endif
#ifndef CHK_MAXOUT
#define CHK_MAXOUT 40u
#endif
__device__ __forceinline__ float bf2f(unsigned short h) { return __uint_as_float((unsigned)h << 16); }
__device__ __forceinline__ void selfcheck_sample(unsigned char* ws, int sidx) {
    const unsigned short* Q = (const unsigned short*)(ws + WS_Q); const unsigned short* CK = (const unsigned short*)(ws + WS_CMPK); const unsigned short* CV = (const unsigned short*)(ws + WS_CMPV);
    const unsigned short* KS = (const unsigned short*)(ws + WS_KS); const unsigned short* VS = (const unsigned short*)(ws + WS_VS);
    const unsigned short* KW = (const unsigned short*)(ws + WS_KW); const unsigned short* VW = (const unsigned short*)(ws + WS_VW);
    const float* GN = (const float*)(ws + WS_GNSA); const unsigned short* YB = (const unsigned short*)(ws + WS_YAB);
    const unsigned* MK = (const unsigned*)(ws + WS_CHKMASK); float* slab = (float*)(ws + WS_CHKSLAB) + (size_t)sidx * 1024;
    unsigned* ctl = (unsigned*)(ws + WS_CTL) + CW_CHK;
    const int b = sidx & 7, head = (sidx >> 3) & 7; const int si = sidx >> 6;
    int t;
    { const int edges[32] = {0, 1, 15, 30, 31, 32, 46, 47, 48, 63, 64, 65, 127, 128, 511, 512, 513, 575, 576, 1023, 1024, 1025, 1087, 1088, 2047, 2048, 3000, 4031, 4032, 4094, 4095, 777};
      unsigned hsh = (unsigned)sidx * 2654435761u; hsh ^= hsh >> 13; t = (int)(hsh % 4096u);
#pragma unroll
      for (int e = 0; e < 32; ++e) if (si == e) t = edges[e]; }
    const int g = head >> 2; const size_t row = (size_t)b * 4096 + t; const size_t bg = (size_t)(b * 2 + g); const int cur = t >> 6;
    for (int j = 0; j < 64; ++j) slab[j] = 0.f;
    const int kmax = (t >= 31) ? ((t - 31) >> 4) : -1;
    for (int hh = 0; hh < 4; ++hh) {
        const unsigned short* q = Q + row * 512 + (4 * g + hh) * 64;
        float mx = -1e30f;
        for (int k = 0; k <= kmax; ++k) { const unsigned short* kr = CK + (bg * 256 + k) * 64; float s = 0.f; for (int d = 0; d < 64; ++d) s += bf2f(q[d]) * bf2f(kr[d]); slab[64 + k] = s; mx = fmaxf(mx, s); }
        float l = 0.f; for (int k = 0; k <= kmax; ++k) { const float e = exp2f(slab[64 + k] - mx); slab[64 + k] = e; l += e; }
        const float inv = l > 0.f ? 1.0f / l : 0.f;
        for (int k = 0; k <= kmax; ++k) { const float p = slab[64 + k] * inv;
            for (int j = 0; j < 64; ++j) if (16 * k < 64 * j + 64 && 16 * k + 32 > 64 * j) slab[j] += p;
            if (4 * g + hh == head) slab[320 + k] = p; }
    }
    for (int j = 0; j < 64; ++j) { const bool forced = (j == 0) || (j == cur) || (j == cur - 1); const bool valid = j <= cur; slab[j] = forced ? 1e9f : (valid ? slab[j] : -1e9f); }
    unsigned mlo = 0u, mhi = 0u;
    for (int r = 0; r < 16; ++r) { int best = -1; float bv = 0.f;
        for (int j = 0; j < 64; ++j) { const bool taken = (j < 32) ? ((mlo >> j) & 1u) : ((mhi >> (j - 32)) & 1u); if (!taken && (best < 0 || slab[j] > bv)) { best = j; bv = slab[j]; } }
        if (best < 32) mlo |= 1u << best; else mhi |= 1u << (best - 32); }
    const unsigned vlo = (cur >= 31) ? 0xffffffffu : ((2u << cur) - 1u), vhi = (cur < 32) ? 0u : ((cur >= 63) ? 0xffffffffu : ((2u << (cur - 32)) - 1u));
    mlo &= vlo; mhi &= vhi;
    const unsigned flo = MK[(row * 2 + g) * 2 + 0], fhi = MK[(row * 2 + g) * 2 + 1];
    if (flo != mlo || fhi != mhi) atomicAdd(ctl + 1, 1u);
    const unsigned short* q = Q + row * 512 + head * 64;
    const float g0 = GN[row * 24 + head * 3 + 0], g1 = GN[row * 24 + head * 3 + 1], g2 = GN[row * 24 + head * 3 + 2];
    float* y = slab + 576;
    for (int d = 0; d < 64; ++d) y[d] = 0.f;
    for (int k = 0; k <= kmax; ++k) { const float p = slab[320 + k] * g0; const unsigned short* vr = CV + (bg * 256 + k) * 64; for (int d = 0; d < 64; ++d) y[d] += p * bf2f(vr[d]); }
    for (int br = 0; br < 2; ++br) {
        const unsigned short* Kp = br ? KW : KS; const unsigned short* Vp = br ? VW : VS;
        float mx = -1e30f;
        for (int pos = 0; pos <= t; ++pos) { const int j = pos >> 6; const bool on = br ? (pos > t - 512) : ((j < 32) ? ((mlo >> j) & 1u) : ((mhi >> (j - 32)) & 1u));
            if (!on) continue; const unsigned short* kr = Kp + (bg * 4096 + pos) * 64; float s = 0.f; for (int d = 0; d < 64; ++d) s += bf2f(q[d]) * bf2f(kr[d]); mx = fmaxf(mx, s); }
        float l = 0.f; float* o = slab + 640;
        for (int d = 0; d < 64; ++d) o[d] = 0.f;
        for (int pos = 0; pos <= t; ++pos) { const int j = pos >> 6; const bool on = br ? (pos > t - 512) : ((j < 32) ? ((mlo >> j) & 1u) : ((mhi >> (j - 32)) & 1u));
            if (!on) continue; const unsigned short* kr = Kp + (bg * 4096 + pos) * 64; float s = 0.f; for (int d = 0; d < 64; ++d) s += bf2f(q[d]) * bf2f(kr[d]);
            const float e = exp2f(s - mx); l += e; const unsigned short* vr = Vp + (bg * 4096 + pos) * 64; for (int d = 0; d < 64; ++d) o[d] += e * bf2f(vr[d]); }
        const float gg = (br ? g2 : g1) / l;
        for (int d = 0; d < 64; ++d) y[d] += gg * o[d];
    }
    float num = 0.f, den = 0.f;
    for (int d = 0; d < 64; ++d) { const float f = bf2f(YB[row * 1024 + head * 64 + d]); num += (f - y[d]) * (f - y[d]); den += y[d] * y[d]; }
    if (!(num <= 0.0009f * den + 1e-9f)) atomicAdd(ctl + 2, 1u);
    atomicAdd(ctl + 0, 1u);
}
#endif

#ifndef REPEAT_MASK
#define REPEAT_MASK 0
#endif
#define NREP(k) (1 + ((REPEAT_MASK >> (k)) & 1))
template <int R> struct RepOrder { pg8::StaticOrder b;
    __device__ __forceinline__ bool next(int i, pg8::Unit& u) const { return b.next(i / R, u); }
    __device__ __forceinline__ void a_ready(const pg8::Unit&) const {}
    __device__ __forceinline__ void done(const pg8::Unit&) const {} };
template <int NR> struct RevOrder { pg8::StaticOrder b;
    __device__ __forceinline__ bool next(int i, pg8::Unit& u) const { return (i < NR) ? b.next(NR - 1 - i, u) : false; }
    __device__ __forceinline__ void a_ready(const pg8::Unit&) const {}
    __device__ __forceinline__ void done(const pg8::Unit&) const {} };
__device__ __forceinline__ const void* ldptr(LAS const unsigned long long* PT, int i) { const unsigned long long v = PT[i];
    const unsigned lo = (unsigned)__builtin_amdgcn_readfirstlane((int)(unsigned)v), hi = (unsigned)__builtin_amdgcn_readfirstlane((int)(unsigned)(v >> 32)); return (const void*)(uintptr_t)(((unsigned long long)hi << 32) | lo); }
struct Args { const void* in[21]; float* out; unsigned char* ws; int ph_lo, ph_hi, li, pad; };
__global__ void __launch_bounds__(NWAVES * 64, 2) nsa_block_fwd(Args args) {
    extern __shared__ __attribute__((aligned(16))) unsigned char lds[];
    LAS unsigned char* L = (LAS unsigned char*)lds;
    volatile LAS unsigned* MISC = (volatile LAS unsigned*)(L + MISC_OFF);
    const int tid0 = threadIdx.x;
#define FRESH_TID() int tid = threadIdx.x; asm volatile("" : "+v"(tid)); const int lane = tid & 63; const int wave = __builtin_amdgcn_readfirstlane(tid >> 6); const int gtid = vcu * (NWAVES * 64) + tid; (void)lane; (void)wave; (void)gtid
    const int G = gridDim.x; const int bx = blockIdx.x; const int vcu = (G % 8 == 0) ? (bx % 8) * (G / 8) + bx / 8 : bx;
    unsigned char* ws = args.ws;
    gu32* ctl = (gu32*)(ws + WS_CTL);
    for (int u = tid0; u < (LDS_BYTES - LDSCTL_OFF) / 4; u += NWAVES * 64) ((LAS unsigned*)(L + LDSCTL_OFF))[u] = 0u;
    __syncthreads();
    LAS unsigned long long* PT = (LAS unsigned long long*)(L + LDSCTL_OFF + 512);
    if (tid0 == 0) {
#pragma unroll
        for (int i = 0; i < 21; ++i) PT[i] = (unsigned long long)(uintptr_t)args.in[i]; }
    __syncthreads();
#define LDP(i) ((const float*)ldptr(PT, (i)))
    Ptrs P; P.out = args.out; P.ws = args.ws;
    XcdBarrier bar; bar.bar = (unsigned*)(ctl + CW_BAR); bar.x = 0; bar.st = nullptr;
    if (N_LAUNCHES == 1) bar = xcd_barrier_post((unsigned*)(ctl + CW_BAR), MISC + 8);
    const int lo = args.ph_lo, hi = args.ph_hi;
#ifndef PHMASK
#define PHMASK 0xff
#endif
#define IN(k) (((PHMASK >> (k)) & 1) && lo <= (k) && (k) < hi)
#define SEAM(k) do { if (IN(k) && IN((k) + 1)) xcd_barrier(bar); } while (0)
    const int nthr = G * NWAVES * 64;

    if (IN(0)) { FRESH_TID(); P.x = LDP(0); P.pos = (const int*)LDP(1); P.n1g = LDP(2); P.win = LDP(3); P.wa = LDP(5); P.kpe = LDP(8); P.kw1 = LDP(9); P.vpe = LDP(11); P.vw1 = LDP(12); P.wb = LDP(14); P.wo = LDP(15); P.n2g = LDP(16); P.wff = LDP(17); P.wdn = LDP(20);
        for (int rep = 0; rep < NREP(0); ++rep) p0_prologue(P, L, vcu, G, wave, lane); SEAM(0); }
    if (IN(1)) {
        pg8::Gemm g{(const pg8::bf16_t*)(ws + WS_H1), (const pg8::bf16_t*)(ws + WS_WIN), T, NIN, DM}; pg8::StaticOrder S; S.init(T, NIN, G, bx);
        pg8::EpiIn E{ws, LDP(6), LDP(7)};
        RepOrder<NREP(1)> SR{S}; pg8::gemm_phase<pg8::EpiIn, RepOrder<NREP(1)>, true, true>(L + RING_OFF, g, SR, E);
        SEAM(1);
    }
    if (IN(2)) { FRESH_TID(); P.kng = LDP(7); P.kw2 = LDP(10); P.vw2 = LDP(13);
        for (int rep = 0; rep < NREP(2); ++rep)
        for (int u = vcu; u < 256; u += G) compress_unit(P, u, L, tid);
        SEAM(2);
    }
    if (IN(3)) {
        const att::AttnP AP{ws, LDP(4), LDP(7)};
#ifndef ATT_DRY
#define ATT_DRY 0
#endif
        if (ATT_DRY) for (int idx = vcu; idx < 1024; idx += G) {
            const int bgi = (idx & 255) >> 4, s = idx & 15, rnd = idx >> 8;
            const int c = (rnd == 0) ? s : (rnd == 1) ? 31 - s : (rnd == 2) ? 32 + s : 63 - s;
            att::attn_unit<ATT_DRY>(bgi >> 1, bgi & 1, c, AP, (char*)lds + RING_OFF);
        }
        for (int idx = vcu; idx < 1024; idx += G) {
            const int bgi = (idx & 255) >> 4, s = idx & 15, rnd = idx >> 8;
            const int c = (rnd == 0) ? s : (rnd == 1) ? 31 - s : (rnd == 2) ? 32 + s : 63 - s;
            att::attn_unit<0>(bgi >> 1, bgi & 1, c, AP, (char*)lds + RING_OFF);
        }
        SEAM(3);
    }
    if (IN(4)) {
#ifdef SELFCHECK
        { const int gt = vcu * (NWAVES * 64) + (int)threadIdx.x; const int sidx = (gt % 64) * 64 + gt / 64;
          if (gt < CHK_NS) selfcheck_sample(ws, sidx); }
        xcd_barrier(bar);
#endif
        pg8::Gemm g{(const pg8::bf16_t*)(ws + WS_YAB), (const pg8::bf16_t*)(ws + WS_WA), T, DM, DM}; pg8::StaticOrder S; S.init(T, DM, G, bx);
        pg8::EpiMerge E{(const pg8::bf16_t*)(ws + WS_GM), (pg8::bf16_t*)(ws + WS_MIX)};
        RepOrder<NREP(4)> SR{S}; pg8::gemm_phase<pg8::EpiMerge, RepOrder<NREP(4)>, true, true>(L + RING_OFF, g, SR, E);
        SEAM(4);
    }
    if (IN(5)) {
        pg8::Gemm g{(const pg8::bf16_t*)(ws + WS_MIX), (const pg8::bf16_t*)(ws + WS_WO), T, DM, DM}; pg8::StaticOrder S; S.init(T, DM, G, bx);
        pg8::EpiWO E{LDP(0), (pg8::bf16_t*)(ws + WS_X1B), (float*)(ws + WS_SSQ)};
        RepOrder<NREP(5)> SR{S}; pg8::gemm_phase<pg8::EpiWO, RepOrder<NREP(5)>, true, true>(L + RING_OFF, g, SR, E);
        SEAM(5);
    }
    if (IN(6)) { FRESH_TID(); P.fcw = LDP(18); P.fcb = LDP(19);
        pg8::Gemm g{(const pg8::bf16_t*)(ws + WS_X1B), (const pg8::bf16_t*)(ws + WS_WFF), T, NFF, DM}; pg8::StaticOrder S; S.init(T, NFF, G, bx);
        { pg8::Unit uu; float* RS = (float*)(ws + WS_RS); const float* SSQ = (const float*)(ws + WS_SSQ);
          int lastpm = -1;
          for (int i = 0; S.next(i, uu); ++i) if (uu.pm != lastpm) { lastpm = uu.pm; if (tid < 256) { const size_t row = (size_t)uu.pm * 256 + tid; float s = 0.f;
#pragma unroll
              for (int j = 0; j < 16; ++j) s += SSQ[row * 16 + j];
              RS[row] = -1.4426950408889634f / sqrtf(s * (1.0f / 1024.0f) + 1e-6f); } }
          VM_WAIT(); __syncthreads(); }
        pg8::EpiFF1 E{(const float*)(ws + WS_RS), (pg8::bf16_t*)(ws + WS_ACT), (float*)(ws + WS_TAIL), (float*)(ws + WS_HEADP), (float*)(ws + WS_HEADU), P.fcw, P.fcb, (LAS float*)(L + LDSCTL_OFF + 1024)};
        RepOrder<NREP(6)> SR{S}; pg8::gemm_phase<pg8::EpiFF1, RepOrder<NREP(6)>, true, true>(L + RING_OFF, g, SR, E);
        SEAM(6);
    }
    if (IN(7)) { FRESH_TID(); P.fcw = LDP(18);
        { pg8::StaticOrder S0; S0.init(T, DM, G, bx); pg8::Unit uu; for (int i = 0; S0.next(i, uu); ++i) ffn_fix_rows(ws, P.fcw, uu.pm, tid); VM_WAIT(); __syncthreads(); }
        pg8::Gemm g{(const pg8::bf16_t*)(ws + WS_ACT), (const pg8::bf16_t*)(ws + WS_WDN), T, DM, DFF}; pg8::StaticOrder S; S.init(T, DM, G, bx);
        pg8::EpiFF2 E{(const pg8::bf16_t*)(ws + WS_X1B), P.out};
        static_assert(T / 256 * (DM / 256) == 2 * 256, "two rounds on 256 CUs");
        if (G == 256) { RevOrder<2> SR{S}; pg8::gemm_phase<pg8::EpiFF2, RevOrder<2>, true, true>(L + RING_OFF, g, SR, E); }
        else { RepOrder<NREP(7)> SR{S}; pg8::gemm_phase<pg8::EpiFF2, RepOrder<NREP(7)>, true, true>(L + RING_OFF, g, SR, E); }
    }
#ifdef SELFCHECK
    if (IN(7)) { xcd_barrier(bar); const unsigned* cc = (const unsigned*)(ws + WS_CTL) + CW_CHK; const unsigned nd = __hip_atomic_load(cc, RLX_AGENT), nm = __hip_atomic_load(cc + 1, RLX_AGENT), no = __hip_atomic_load(cc + 2, RLX_AGENT);
        const bool bad = (nd != (unsigned)CHK_NS) || (nm > CHK_MAXMASK) || (no > CHK_MAXOUT);
        if (bad && blockIdx.x == 0) { for (int i = threadIdx.x; i < 4096; i += NWAVES * 64) P.out[i] = __builtin_nanf(""); } }
#endif
#undef IN
#undef SEAM
}

extern "C" void kernel_launch(void* const* d_in, const int* in_sizes, int n_in, void* d_out, int out_size, void* d_ws, size_t ws_size, hipStream_t stream) {
    static int grid = 0;
    if (grid == 0) {
        if (n_in != 21 || in_sizes[0] != T * DM || out_size != T * DM || ws_size < WS_END) {
            fprintf(stderr, "kernel_launch: unexpected problem: n_in %d in0 %d out %d ws %zu (need >= %zu)\n", n_in, n_in > 0 ? in_sizes[0] : -1, out_size, ws_size, (size_t)WS_END); grid = -1; return; }
        int dev = 0, cus = 0, per_cu = 0;
        if (hipGetDevice(&dev) != hipSuccess || hipDeviceGetAttribute(&cus, hipDeviceAttributeMultiprocessorCount, dev) != hipSuccess) { fprintf(stderr, "kernel_launch: device query failed\n"); grid = -1; return; }
        if (hipFuncSetAttribute((const void*)nsa_block_fwd, hipFuncAttributeMaxDynamicSharedMemorySize, LDS_BYTES) != hipSuccess) { fprintf(stderr, "kernel_launch: hipFuncSetAttribute failed\n"); grid = -1; return; }
        if (hipOccupancyMaxActiveBlocksPerMultiprocessor(&per_cu, (const void*)nsa_block_fwd, NWAVES * 64, LDS_BYTES) != hipSuccess || per_cu < 1)
            fprintf(stderr, "kernel_launch: occupancy query reports %d workgroups per CU\n", per_cu);
        (void)hipGetLastError();
        grid = cus;
    }
    if (grid < 0) return;
    if (hipMemsetAsync((char*)d_ws + WS_CTL, 0, CTL_ZERO_BYTES, stream) != hipSuccess) { fprintf(stderr, "kernel_launch: memset failed\n"); return; }
    Args a{};
    for (int i = 0; i < 21; ++i) a.in[i] = d_in[i];
    a.out = (float*)d_out; a.ws = (unsigned char*)d_ws;
    for (int li = 0; li < N_LAUNCHES; ++li) {
        a.ph_lo = (N_LAUNCHES == 1) ? 0 : li; a.ph_hi = (N_LAUNCHES == 1) ? N_PHASES : li + 1; a.li = li;
        hipLaunchKernelGGL(nsa_block_fwd, dim3(grid), dim3(NWAVES * 64), LDS_BYTES, stream, a);
        const hipError_t le = hipPeekAtLastError();
        if (le != hipSuccess) { fprintf(stderr, "kernel_launch: launch %d failed: %s\n", li, hipGetErrorName(le)); break; }
    }
}
```
